# Optimizing an MI355X kernel written in HIP

```python
import jax, jax.numpy as jnp
from jax import lax
import numpy as np

D_MODEL = 1024
BATCH = 2
SEQ = 8192
DEPTH = 4

A_WIDTH = D_MODEL // 2
A_GROUPS = 8
A_GROUP_DIM = A_WIDTH // A_GROUPS
CHUNK = 128
B_WIDTH = D_MODEL // 2
CONV_WIDTH = 31
AB_IN = 2 * A_WIDTH + 2 * B_WIDTH
AB_OUT = A_WIDTH + B_WIDTH
HEAD_DIM = 64
C_HEADS = D_MODEL // HEAD_DIM
C_WIDTH = C_HEADS * HEAD_DIM
DILATED_PATTERNS = ((128, 1), (512, 4), (2048, 16))
ROT_DIM = HEAD_DIM // 4
ROPE_THETA = 500000.0
D_FF = 4 * D_MODEL
EPS = 1e-6
NEG = -1e30
N_EVEN = (DEPTH + 1) // 2
N_ODD = DEPTH // 2

kernel_name = "hybrid_gmlp_conv_dilated_attn_encoder"


def rmsnorm(t, g):
    tf = t.astype(jnp.float32)
    y = tf * lax.rsqrt(jnp.mean(tf * tf, axis=-1, keepdims=True) + EPS)
    return (y * g.astype(jnp.float32)).astype(t.dtype)


def layernorm(t, g, b):
    tf = t.astype(jnp.float32)
    mu = jnp.mean(tf, axis=-1, keepdims=True)
    var = jnp.mean(jnp.square(tf - mu), axis=-1, keepdims=True)
    y = (tf - mu) * lax.rsqrt(var + EPS)
    return (y * g.astype(jnp.float32) + b.astype(jnp.float32)).astype(t.dtype)


def rope_tables(seq):
    pos = jnp.arange(seq, dtype=jnp.float32)
    inv_freq = ROPE_THETA ** (-jnp.arange(0, ROT_DIM, 2, dtype=jnp.float32) / ROT_DIM)
    ang = pos[:, None] * inv_freq[None, :]
    return jnp.cos(ang), jnp.sin(ang)


def partial_rope(t, cos, sin):
    half = ROT_DIM // 2
    t1 = t[..., :half].astype(jnp.float32)
    t2 = t[..., half:ROT_DIM].astype(jnp.float32)
    c, s = cos[:, None, :], sin[:, None, :]
    rot = jnp.concatenate([t1 * c - t2 * s, t2 * c + t1 * s], axis=-1).astype(t.dtype)
    return jnp.concatenate([rot, t[..., ROT_DIM:]], axis=-1)


def dilated_band_attention(q, k, v, window, dilation):
    B, S, H, hd = q.shape
    half = window // (2 * dilation)
    blk = half
    L = S // dilation
    nb = -(-L // blk)
    Lp = nb * blk

    def to_strided(t):
        return t.reshape(B, L, dilation, H, hd).transpose(0, 2, 3, 1, 4)

    qs, ks, vs = to_strided(q), to_strided(k), to_strided(v)
    qb = jnp.pad(qs, ((0, 0),) * 3 + ((0, Lp - L), (0, 0))).reshape(B, dilation, H, nb, blk, hd)
    pad_kv = ((0, 0),) * 3 + ((blk, Lp - L + blk), (0, 0))
    ks, vs = jnp.pad(ks, pad_kv), jnp.pad(vs, pad_kv)

    def key_blocks(t):
        return jnp.concatenate(
            [t[..., o * blk:o * blk + Lp, :].reshape(B, dilation, H, nb, blk, hd) for o in range(3)],
            axis=-2)

    kb, vb = key_blocks(ks), key_blocks(vs)
    qi = jnp.arange(nb)[:, None, None] * blk + jnp.arange(blk)[None, :, None]
    kj = jnp.arange(nb)[:, None, None] * blk + jnp.arange(3 * blk)[None, None, :] - blk
    mask = (jnp.abs(kj - qi) <= half) & (kj >= 0) & (kj < L)

    s = jnp.einsum('brhnqd,brhnkd->brhnqk', qb.astype(jnp.float32), kb.astype(jnp.float32)) * (hd ** -0.5)
    s = jnp.where(mask, s, NEG)
    m = jnp.max(s, axis=-1, keepdims=True)
    p = jnp.exp(s - m)
    denom = jnp.sum(p, axis=-1, keepdims=True)
    o = jnp.einsum('brhnqk,brhnkd->brhnqd', p, vb.astype(jnp.float32)) / denom
    lse = (m + jnp.log(denom))[..., 0]
    o = o.reshape(B, dilation, H, Lp, hd)[..., :L, :].transpose(0, 3, 1, 2, 4).reshape(B, S, H, hd)
    lse = lse.reshape(B, dilation, H, Lp)[..., :L].transpose(0, 3, 1, 2).reshape(B, S, H)
    return o, lse


def mixer_ab(h, w_in, sp_w, sp_b, v_g, v_b, conv_w, conv_b, cn_g, cn_b, w_out):
    B, S, _ = h.shape
    z = h @ w_in
    za = jax.nn.gelu(z[..., :2 * A_WIDTH])
    u, v = za[..., :A_WIDTH], za[..., A_WIDTH:]
    v = layernorm(v, v_g, v_b)
    vc = v.reshape(B, S // CHUNK, CHUNK, A_GROUPS, A_GROUP_DIM)
    sv = jnp.einsum('gpq,bnqgc->bnpgc', sp_w, vc) + sp_b.T[:, :, None]
    ya = u * sv.reshape(B, S, A_WIDTH)
    zb = z[..., 2 * A_WIDTH:]
    g = zb[..., :B_WIDTH] * jax.nn.sigmoid(zb[..., B_WIDTH:])
    g = lax.conv_general_dilated(
        g, conv_w[:, None, :].astype(g.dtype), window_strides=(1,),
        padding=((CONV_WIDTH // 2, CONV_WIDTH // 2),),
        dimension_numbers=('NWC', 'WIO', 'NWC'), feature_group_count=B_WIDTH) + conv_b
    yb = jax.nn.silu(layernorm(g, cn_g, cn_b))
    return jnp.concatenate([ya, yb], axis=-1) @ w_out


def mixer_c(h, w_qkv, q_g, k_g, w_out, cos, sin):
    B, S, _ = h.shape
    qkv = (h @ w_qkv).reshape(B, S, 3, C_HEADS, HEAD_DIM)
    q = partial_rope(rmsnorm(qkv[:, :, 0], q_g), cos, sin)
    k = partial_rope(rmsnorm(qkv[:, :, 1], k_g), cos, sin)
    v = qkv[:, :, 2]
    outs, lses = [], []
    for window, dilation in DILATED_PATTERNS:
        o, l = dilated_band_attention(q, k, v, window, dilation)
        outs.append(o)
        lses.append(l)
    wts = jax.nn.softmax(jnp.stack(lses), axis=0)
    o = jnp.einsum('pbsh,pbshd->bshd', wts, jnp.stack(outs))
    return o.reshape(B, S, C_WIDTH).astype(h.dtype) @ w_out


def squared_relu_mlp(h, w1, w2):
    return jnp.square(jax.nn.relu(h @ w1)) @ w2


def setup_inputs(seed: int = 0) -> dict:
    key = jax.random.key(seed)
    ks = jax.random.split(key, 20)

    def nrm(k, shape, scale):
        return jax.random.normal(k, shape, jnp.float32) * scale

    res = (2 * DEPTH) ** -0.5
    return {
        "x": nrm(ks[0], (BATCH, SEQ, D_MODEL), 1.0),
        "mix_norm_g": 1.0 + nrm(ks[1], (DEPTH, D_MODEL), 0.02),
        "mlp_norm_g": 1.0 + nrm(ks[2], (DEPTH, D_MODEL), 0.02),
        "mlp_w1": nrm(ks[3], (DEPTH, D_MODEL, D_FF), D_MODEL ** -0.5),
        "mlp_w2": nrm(ks[4], (DEPTH, D_FF, D_MODEL), D_FF ** -0.5 * res),
        "ab_w_in": nrm(ks[5], (N_EVEN, D_MODEL, AB_IN), D_MODEL ** -0.5),
        "a_spatial_w": nrm(ks[6], (N_EVEN, A_GROUPS, CHUNK, CHUNK), 0.5 * CHUNK ** -0.5),
        "a_spatial_b": 1.0 + nrm(ks[7], (N_EVEN, A_GROUPS, CHUNK), 0.02),
        "a_vnorm_g": 1.0 + nrm(ks[8], (N_EVEN, A_WIDTH), 0.02),
        "a_vnorm_b": nrm(ks[9], (N_EVEN, A_WIDTH), 0.02),
        "b_conv_w": nrm(ks[10], (N_EVEN, CONV_WIDTH, B_WIDTH), CONV_WIDTH ** -0.5),
        "b_conv_b": nrm(ks[11], (N_EVEN, B_WIDTH), 0.02),
        "b_norm_g": 1.0 + nrm(ks[12], (N_EVEN, B_WIDTH), 0.02),
        "b_norm_b": nrm(ks[13], (N_EVEN, B_WIDTH), 0.02),
        "ab_w_out": nrm(ks[14], (N_EVEN, AB_OUT, D_MODEL), AB_OUT ** -0.5 * res),
        "c_w_qkv": nrm(ks[15], (N_ODD, D_MODEL, 3 * C_WIDTH), D_MODEL ** -0.5),
        "c_q_norm_g": 1.0 + nrm(ks[16], (N_ODD, HEAD_DIM), 0.02),
        "c_k_norm_g": 1.0 + nrm(ks[17], (N_ODD, HEAD_DIM), 0.02),
        "c_w_out": nrm(ks[18], (N_ODD, C_WIDTH, D_MODEL), C_WIDTH ** -0.5 * res),
    }


def reference(x, mix_norm_g, mlp_norm_g, mlp_w1, mlp_w2, ab_w_in, a_spatial_w, a_spatial_b,
              a_vnorm_g, a_vnorm_b, b_conv_w, b_conv_b, b_norm_g, b_norm_b, ab_w_out,
              c_w_qkv, c_q_norm_g, c_k_norm_g, c_w_out):
    cos, sin = rope_tables(x.shape[1])
    for layer in range(DEPTH):
        i = layer // 2
        h = rmsnorm(x, mix_norm_g[layer])
        if layer % 2 == 0:
            x = x + mixer_ab(h, ab_w_in[i], a_spatial_w[i], a_spatial_b[i], a_vnorm_g[i], a_vnorm_b[i],
                             b_conv_w[i], b_conv_b[i], b_norm_g[i], b_norm_b[i], ab_w_out[i])
        else:
            x = x + mixer_c(h, c_w_qkv[i], c_q_norm_g[i], c_k_norm_g[i], c_w_out[i], cos, sin)
        h = rmsnorm(x, mlp_norm_g[layer])
        x = x + squared_relu_mlp(h, mlp_w1[layer], mlp_w2[layer])
    return x
```

```cpp
#include <hip/hip_runtime.h>
#include <hip/hip_cooperative_groups.h>
#include <cstdio>
#include <cstdint>
namespace cg = cooperative_groups;
namespace pg8 {
#define PG8_LAS __attribute__((address_space(3)))
typedef unsigned short bf16_t;
typedef short bf16x8 __attribute__((ext_vector_type(8)));
typedef float f32x4 __attribute__((ext_vector_type(4)));
typedef unsigned u32x4 __attribute__((ext_vector_type(4)));
constexpr int BM = 256, BK = 64, HALF = 128, HTB = HALF * BK * 2  , STAGE_BYTES = 8 * HTB, NXCD = 8, WGM = 8;

__host__ __device__ __forceinline__ int lds_byte(int r, int c) { const int st = (r >> 4) * 2 + (c >> 5), rr = r & 15, cc = c & 31, ob = rr * 64 + cc * 2; return st * 1024 + (ob ^ (((ob >> 9) & 1) << 5)); }
__host__ __device__ __forceinline__ void stage_rc(int b, int& R, int& C) { const int st = b / 1024, sb = b % 1024, swz = sb ^ (((sb >> 9) & 1) << 5); R = (st >> 1) * 16 + swz / 64; C = (st & 1) * 32 + (swz % 64) / 2; }
__host__ __device__ __forceinline__ int perm32(int rho) { const int n = rho >> 4, i = rho & 15; return 8 * (i >> 2) + 4 * n + (i & 3); }

struct Unit { int pm, pn; };
struct Gemm { const bf16_t* A; const bf16_t* Bt; int M, N, K; };

struct StaticOrder {
    int nM, nN, nwg, G, c, wgm;
    __host__ __device__ void init(int M, int N, int G_, int c_, int wgm_ = 2) { nM = M / BM; nN = N / BM; nwg = nM * nN; G = G_; c = c_; wgm = wgm_; }
    __host__ __device__ bool next(int i, Unit& u) const {
        const long L = (long)i * G + c; if (L >= nwg) return false;
        int wgid = (int)L; { const int q = nwg / NXCD, r = nwg % NXCD, xcd = wgid % NXCD, off = wgid / NXCD; wgid = (xcd < r ? xcd * (q + 1) : r * (q + 1) + (xcd - r) * q) + off; }
        const int nig = wgm * nN, gid = wgid / nig, fm = gid * wgm, gsz = (nM - fm) < wgm ? (nM - fm) : wgm;
        u.pm = fm + ((wgid % nig) % gsz); u.pn = (wgid % nig) / gsz; return true;
    }
    __device__ __forceinline__ void a_ready(const Unit&) const {}
    __device__ __forceinline__ void done(const Unit&) const {}
};

typedef unsigned u32x2 __attribute__((ext_vector_type(2)));
__device__ __forceinline__ unsigned cvt_pk_bf16(float lo, float hi) { unsigned r; asm volatile("v_cvt_pk_bf16_f32 %0, %1, %2" : "=v"(r) : "v"(lo), "v"(hi)); return r; }
__device__ __forceinline__ float row_rstd16(const float* rowsq, int row) {
    const f32x4* p = (const f32x4*)(rowsq + (size_t)row * 16);
    const f32x4 a = p[0], b = p[1], c = p[2], d = p[3];
    const float s = ((a[0] + a[1]) + (a[2] + a[3])) + ((b[0] + b[1]) + (b[2] + b[3])) + ((c[0] + c[1]) + (c[2] + c[3])) + ((d[0] + d[1]) + (d[2] + d[3]));
    return __builtin_amdgcn_rsqf(s * (1.0f / 1024.0f) + 1e-6f);
}
__device__ __forceinline__ float gelu_tanh(float x) {
    const float t = 0.7978845608028654f * (x + 0.044715f * x * x * x);
    const float e = __builtin_amdgcn_exp2f(-2.0f * 1.4426950408889634f * t);
    return x * __builtin_amdgcn_rcpf(1.0f + e);
}
__device__ __forceinline__ float sigmoidf_(float x) { return __builtin_amdgcn_rcpf(1.0f + __builtin_amdgcn_exp2f(-1.4426950408889634f * x)); }

struct EpiZ {
    static constexpr bool PERM = true, AFTER_DRAIN = false;
    bf16_t* UV; bf16_t* Gb; const float* rowsq; PG8_LAS float* tab;
    __device__ __forceinline__ void operator()(const f32x4 (&acc)[2][2][4][2], const Unit& u, int wr, int wc, int fr, int fq) const {
        const int row0 = u.pm * BM + wr * 64 + fr;
        PG8_LAS float* tb = tab + (wr * 4 + wc) * 128;
#pragma unroll
        for (int ai = 0; ai < 2; ++ai) tb[ai * 64 + fq * 16 + fr] = row_rstd16(rowsq, u.pm * BM + ai * HALF + wr * 64 + fq * 16 + fr);
#pragma unroll
        for (int ai = 0; ai < 2; ++ai)
#pragma unroll
            for (int m = 0; m < 4; ++m) {
                const int row = row0 + ai * HALF + m * 16; const float rs = tb[ai * 64 + m * 16 + fr];
                if (u.pn < 4) {
                    bf16_t* rowp = UV + (size_t)row * 1024 + u.pn * BM + wc * 32 + 8 * fq;
#pragma unroll
                    for (int bj = 0; bj < 2; ++bj) { const f32x4 v0 = acc[ai][bj][m][0] * rs, v1 = acc[ai][bj][m][1] * rs; u32x4 w;
                        w.x = cvt_pk_bf16(gelu_tanh(v0[0]), gelu_tanh(v0[1])); w.y = cvt_pk_bf16(gelu_tanh(v0[2]), gelu_tanh(v0[3]));
                        w.z = cvt_pk_bf16(gelu_tanh(v1[0]), gelu_tanh(v1[1])); w.w = cvt_pk_bf16(gelu_tanh(v1[2]), gelu_tanh(v1[3]));
                        *(u32x4*)(rowp + bj * HALF) = w; }
                } else {
                    bf16_t* rowp = Gb + (size_t)row * 512 + (u.pn - 4) * 128 + wc * 32 + 8 * fq;
                    const f32x4 a0 = acc[ai][0][m][0] * rs, a1 = acc[ai][0][m][1] * rs, g0 = acc[ai][1][m][0] * rs, g1 = acc[ai][1][m][1] * rs; u32x4 w;
                    w.x = cvt_pk_bf16(a0[0] * sigmoidf_(g0[0]), a0[1] * sigmoidf_(g0[1])); w.y = cvt_pk_bf16(a0[2] * sigmoidf_(g0[2]), a0[3] * sigmoidf_(g0[3]));
                    w.z = cvt_pk_bf16(a1[0] * sigmoidf_(g1[0]), a1[1] * sigmoidf_(g1[1])); w.w = cvt_pk_bf16(a1[2] * sigmoidf_(g1[2]), a1[3] * sigmoidf_(g1[3]));
                    *(u32x4*)rowp = w;
                }
            }
    }
};
struct EpiW1 {
    static constexpr bool PERM = true, AFTER_DRAIN = false;
    bf16_t* O; const float* rowsq; PG8_LAS float* tab;
    __device__ __forceinline__ void operator()(const f32x4 (&acc)[2][2][4][2], const Unit& u, int wr, int wc, int fr, int fq) const {
        const int row0 = u.pm * BM + wr * 64 + fr;
        PG8_LAS float* tb = tab + (wr * 4 + wc) * 128;
#pragma unroll
        for (int ai = 0; ai < 2; ++ai) tb[ai * 64 + fq * 16 + fr] = row_rstd16(rowsq, u.pm * BM + ai * HALF + wr * 64 + fq * 16 + fr);
#pragma unroll
        for (int ai = 0; ai < 2; ++ai)
#pragma unroll
            for (int m = 0; m < 4; ++m) {
                const int row = row0 + ai * HALF + m * 16; const float rs = tb[ai * 64 + m * 16 + fr];
                bf16_t* rowp = O + (size_t)row * 4096 + u.pn * BM + wc * 32 + 8 * fq;
#pragma unroll
                for (int bj = 0; bj < 2; ++bj) { f32x4 v0 = acc[ai][bj][m][0] * rs, v1 = acc[ai][bj][m][1] * rs; u32x4 w;
#pragma unroll
                    for (int e = 0; e < 4; ++e) { const float a = fmaxf(v0[e], 0.f), b = fmaxf(v1[e], 0.f); v0[e] = a * a; v1[e] = b * b; }
                    w.x = cvt_pk_bf16(v0[0], v0[1]); w.y = cvt_pk_bf16(v0[2], v0[3]); w.z = cvt_pk_bf16(v1[0], v1[1]); w.w = cvt_pk_bf16(v1[2], v1[3]);
                    *(u32x4*)(rowp + bj * HALF) = w; }
            }
    }
};
struct EpiRes {
    static constexpr bool PERM = true, AFTER_DRAIN = false;
    bf16_t* xb; float* rowsq; float* outf;
    __device__ __forceinline__ void operator()(const f32x4 (&acc)[2][2][4][2], const Unit& u, int wr, int wc, int fr, int fq) const {
        const int row0 = u.pm * BM + wr * 64 + fr, col0 = u.pn * BM + wc * 32 + 8 * fq;
#pragma unroll
        for (int ai = 0; ai < 2; ++ai) {
            u32x4 pre[4][2];
#pragma unroll
            for (int m = 0; m < 4; ++m)
#pragma unroll
                for (int bj = 0; bj < 2; ++bj) pre[m][bj] = *(const u32x4*)(xb + (size_t)(row0 + ai * HALF + m * 16) * 1024 + col0 + bj * HALF);
            asm volatile("" ::: "memory");
#pragma unroll
            for (int m = 0; m < 4; ++m) {
                const int row = row0 + ai * HALF + m * 16; const size_t off = (size_t)row * 1024 + col0; float ss = 0.f;
#pragma unroll
                for (int bj = 0; bj < 2; ++bj) {
                    const u32x4 w = pre[m][bj];
                    f32x4 v0 = acc[ai][bj][m][0], v1 = acc[ai][bj][m][1];
                    v0[0] += __uint_as_float(w.x << 16); v0[1] += __uint_as_float(w.x & 0xffff0000u); v0[2] += __uint_as_float(w.y << 16); v0[3] += __uint_as_float(w.y & 0xffff0000u);
                    v1[0] += __uint_as_float(w.z << 16); v1[1] += __uint_as_float(w.z & 0xffff0000u); v1[2] += __uint_as_float(w.w << 16); v1[3] += __uint_as_float(w.w & 0xffff0000u);
                    if (outf) { *(f32x4*)(outf + off + bj * HALF) = v0; *(f32x4*)(outf + off + bj * HALF + 4) = v1; }
                    else {
                        ss += ((v0[0] * v0[0] + v0[1] * v0[1]) + (v0[2] * v0[2] + v0[3] * v0[3])) + ((v1[0] * v1[0] + v1[1] * v1[1]) + (v1[2] * v1[2] + v1[3] * v1[3]));
                        u32x4 o; o.x = cvt_pk_bf16(v0[0], v0[1]); o.y = cvt_pk_bf16(v0[2], v0[3]); o.z = cvt_pk_bf16(v1[0], v1[1]); o.w = cvt_pk_bf16(v1[2], v1[3]);
                        *(u32x4*)(xb + off + bj * HALF) = o;
                    }
                }
                if (!outf) { ss += __shfl_xor(ss, 16); ss += __shfl_xor(ss, 32); if (fq == 0) rowsq[(size_t)row * 16 + u.pn * 4 + wc] = ss; }
            }
            asm volatile("" ::: "memory");
        }
    }
};
struct EpiQKV {
    static constexpr bool PERM = true, AFTER_DRAIN = false;
    bf16_t* Q; bf16_t* K; bf16_t* V; const float* rowsq; const float* qg; const float* kg; const float* ropeC; const float* ropeS; PG8_LAS float* tab;
    __device__ __forceinline__ void operator()(const f32x4 (&acc)[2][2][4][2], const Unit& u, int wr, int wc, int fr, int fq) const {
        const int row0 = u.pm * BM + wr * 64 + fr;
        PG8_LAS float* tb = tab + (wr * 4 + wc) * 128;
#pragma unroll
        for (int ai = 0; ai < 2; ++ai) tb[ai * 64 + fq * 16 + fr] = row_rstd16(rowsq, u.pm * BM + ai * HALF + wr * 64 + fq * 16 + fr);
        if (u.pn >= 8) {
#pragma unroll
            for (int ai = 0; ai < 2; ++ai)
#pragma unroll
                for (int m = 0; m < 4; ++m) {
                    const int row = row0 + ai * HALF + m * 16; const float rs = tb[ai * 64 + m * 16 + fr];
                    bf16_t* rowp = V + (size_t)row * 1024 + (u.pn - 8) * BM + wc * 32 + 8 * fq;
#pragma unroll
                    for (int bj = 0; bj < 2; ++bj) { const f32x4 v0 = acc[ai][bj][m][0] * rs, v1 = acc[ai][bj][m][1] * rs; u32x4 w;
                        w.x = cvt_pk_bf16(v0[0], v0[1]); w.y = cvt_pk_bf16(v0[2], v0[3]); w.z = cvt_pk_bf16(v1[0], v1[1]); w.w = cvt_pk_bf16(v1[2], v1[3]);
                        *(u32x4*)(rowp + bj * HALF) = w; }
                }
            return;
        }
        const bool isq = u.pn < 4; const int head = 4 * (u.pn & 3) + wc; const float* gp = isq ? qg : kg; bf16_t* dst = isq ? Q : K;
        const float osc = isq ? 0.125f * 1.4426950408889634f : 1.0f;
        f32x4 gv[2][2];
#pragma unroll
        for (int bj = 0; bj < 2; ++bj)
#pragma unroll
            for (int n = 0; n < 2; ++n) gv[bj][n] = *(const f32x4*)(gp + bj * 32 + 8 * fq + 4 * n) * osc;
#pragma unroll
        for (int aim = 0; aim < 4; ++aim) {
            const int ai = aim >> 1;
            f32x4 rc[4][2], rsn[4][2];
#pragma unroll
            for (int m = 2 * (aim & 1); m < 2 * (aim & 1) + 2; ++m)
#pragma unroll
                for (int n = 0; n < 2; ++n) { const int pos = (row0 + ai * HALF + m * 16) & 8191; rc[m][n] = *(const f32x4*)(ropeC + pos * 8 + 4 * n); rsn[m][n] = *(const f32x4*)(ropeS + pos * 8 + 4 * n); }
            asm volatile("" ::: "memory");
#pragma unroll
            for (int m = 2 * (aim & 1); m < 2 * (aim & 1) + 2; ++m) {
                const int row = row0 + ai * HALF + m * 16; const float rs = tb[ai * 64 + m * 16 + fr];
                f32x4 v[2][2]; float ss = 0.f;
#pragma unroll
                for (int bj = 0; bj < 2; ++bj)
#pragma unroll
                    for (int n = 0; n < 2; ++n) { v[bj][n] = acc[ai][bj][m][n] * rs; const f32x4 t = v[bj][n]; ss += (t[0] * t[0] + t[1] * t[1]) + (t[2] * t[2] + t[3] * t[3]); }
                ss += __shfl_xor(ss, 16); ss += __shfl_xor(ss, 32);
                const float hr = __builtin_amdgcn_rsqf(ss * (1.0f / 64.0f) + 1e-6f);
#pragma unroll
                for (int bj = 0; bj < 2; ++bj)
#pragma unroll
                    for (int n = 0; n < 2; ++n) v[bj][n] = v[bj][n] * hr * gv[bj][n];
#pragma unroll
                for (int n = 0; n < 2; ++n) {
                    const f32x4 c = rc[m][n], s = rsn[m][n];
                    f32x4 mine = v[0][n], other;
#pragma unroll
                    for (int e = 0; e < 4; ++e) other[e] = __shfl_xor(mine[e], 16);
                    if (fq == 0) v[0][n] = mine * c - other * s;
                    else if (fq == 1) v[0][n] = mine * c + other * s;
                }
                bf16_t* rowp = dst + (size_t)row * 1024 + head * 64 + 8 * fq;
#pragma unroll
                for (int bj = 0; bj < 2; ++bj) { u32x4 w; w.x = cvt_pk_bf16(v[bj][0][0], v[bj][0][1]); w.y = cvt_pk_bf16(v[bj][0][2], v[bj][0][3]);
                    w.z = cvt_pk_bf16(v[bj][1][0], v[bj][1][1]); w.w = cvt_pk_bf16(v[bj][1][2], v[bj][1][3]); *(u32x4*)(rowp + bj * 32) = w; }
            }
            asm volatile("" ::: "memory");
        }
    }
};
template <class Epi, class Sched, bool ALIGN_EPI = false, bool SP2 = false>
__device__ __forceinline__ void gemm_phase(PG8_LAS unsigned char* lds, const Gemm g, const Sched& S, const Epi& E) {
    int tid = threadIdx.x; asm volatile("" : "+v"(tid));
    const int wid = __builtin_amdgcn_readfirstlane(tid >> 6), lane = tid & 63, wr = wid >> 2, wc = wid & 3, fr = lane & 15, fq = lane >> 4;
    const int K = g.K, nt = K / BK;
    unsigned voffA[2], voffB[2];
#pragma unroll
    for (int i = 0; i < 2; ++i) { int R, C; stage_rc(tid * 16 + i * 8192, R, C); const int Rb = Epi::PERM ? ((R & ~31) + perm32(R & 31)) : R;
        voffA[i] = (unsigned)(R * K + C) * 2u; voffB[i] = (unsigned)(Rb * K + C) * 2u; }
    const size_t kstep = (size_t)(BK * 2);
    const size_t hstep = (size_t)HALF * K * 2;
    const size_t tstep = 2 * hstep;
    const unsigned ldsw = (unsigned)wid * 1024u;
    const int aoff = lds_byte(wr * 64 + fr, fq * 8), boff = lds_byte(wc * 32 + fr, fq * 8);
#define PG8_SA(b, h) (((b) * 2 + (h)) * HTB)
#define PG8_SB(b, h) ((4 + (b) * 2 + (h)) * HTB)
#define PG8_STAGE(bufoff, gbase, voff) do { _Pragma("unroll") for (int _i = 0; _i < 2; ++_i) \
        __builtin_amdgcn_global_load_lds((const unsigned*)((const char*)(gbase) + (voff)[_i]), (PG8_LAS unsigned*)(lds + (bufoff) + ldsw + _i * 8192), 16, 0, 0); } while (0)
#define PG8_LDA(dst, b, h) do { _Pragma("unroll") for (int m = 0; m < 4; ++m) _Pragma("unroll") for (int k = 0; k < 2; ++k) dst[m][k] = *(const PG8_LAS bf16x8*)(lds + PG8_SA(b, h) + aoff + m * 2048 + k * 1024); } while (0)
#define PG8_LDB(dst, b, h) do { _Pragma("unroll") for (int n = 0; n < 2; ++n) _Pragma("unroll") for (int k = 0; k < 2; ++k) dst[n][k] = *(const PG8_LAS bf16x8*)(lds + PG8_SB(b, h) + boff + n * 2048 + k * 1024); } while (0)
#define PG8_MMA(ai, bj, At, Bt) do { __builtin_amdgcn_s_setprio(1); _Pragma("unroll") for (int m = 0; m < 4; ++m) _Pragma("unroll") for (int n = 0; n < 2; ++n) _Pragma("unroll") for (int k = 0; k < 2; ++k) \
        acc[ai][bj][m][n] = __builtin_amdgcn_mfma_f32_16x16x32_bf16(Bt[n][k], At[m][k], acc[ai][bj][m][n], 0, 0, 0); __builtin_amdgcn_s_setprio(0); } while (0)
#define PG8_WAIT_V(n) asm volatile("s_waitcnt vmcnt(" #n ")" ::: "memory")
#define PG8_WAIT_L(n) asm volatile("s_waitcnt lgkmcnt(" #n ")" ::: "memory")
#define PG8_BAR __builtin_amdgcn_s_barrier()
#define PG8_SCHED __builtin_amdgcn_sched_barrier(0)
    Unit cur, nxt; int ui = 0;
    if (!S.next(0, cur)) return;
    f32x4 acc[2][2][4][2];
#pragma unroll
    for (int a = 0; a < 2; ++a)
#pragma unroll
        for (int b = 0; b < 2; ++b)
#pragma unroll
            for (int m = 0; m < 4; ++m)
#pragma unroll
                for (int n = 0; n < 2; ++n) acc[a][b][m][n] = (f32x4){0.f, 0.f, 0.f, 0.f};
    bf16x8 At[4][2], B0[2][2], B1[2][2];
    const char* cA = (const char*)g.A + (size_t)cur.pm * tstep; const char* cB = (const char*)g.Bt + (size_t)cur.pn * tstep;
    S.a_ready(cur);
    if constexpr (SP2) {
        PG8_STAGE(PG8_SB(0, 0), cB, voffB); PG8_STAGE(PG8_SB(0, 1), cB + hstep, voffB); PG8_STAGE(PG8_SA(0, 0), cA, voffA); PG8_STAGE(PG8_SA(0, 1), cA + hstep, voffA);
        if (wr == 1) PG8_BAR;
        PG8_WAIT_V(2); PG8_BAR;
        PG8_STAGE(PG8_SB(1, 0), cB + kstep, voffB); PG8_STAGE(PG8_SA(1, 0), cA + kstep, voffA); PG8_STAGE(PG8_SB(1, 1), cB + hstep + kstep, voffB);
        PG8_WAIT_V(6); PG8_BAR;
    } else {
        PG8_STAGE(PG8_SB(0, 0), cB, voffB); PG8_STAGE(PG8_SA(0, 0), cA, voffA); PG8_STAGE(PG8_SB(0, 1), cB + hstep, voffB); PG8_STAGE(PG8_SA(0, 1), cA + hstep, voffA);
        if (wr == 1) PG8_BAR;
        PG8_WAIT_V(4); PG8_BAR;
        PG8_STAGE(PG8_SB(1, 0), cB + kstep, voffB); PG8_STAGE(PG8_SA(1, 0), cA + kstep, voffA); PG8_STAGE(PG8_SB(1, 1), cB + hstep + kstep, voffB);
        PG8_WAIT_V(6); PG8_BAR;
    }
    for (;;) {
        const bool has_next = S.next(ui + 1, nxt);
        const char* nA = has_next ? (const char*)g.A + (size_t)nxt.pm * tstep : cA; const char* nB = has_next ? (const char*)g.Bt + (size_t)nxt.pn * tstep : cB;
        for (int t = 0; t < nt; t += 2) {
            const bool last = (t == nt - 2);
            const char* a1 = cA + (size_t)(t + 1) * kstep;
            const char* a2 = last ? nA : cA + (size_t)(t + 2) * kstep; const char* b2 = last ? nB : cB + (size_t)(t + 2) * kstep;
            const char* a3 = a2 + kstep; const char* b3 = b2 + kstep;
            if (last && has_next) S.a_ready(nxt);
            if constexpr (SP2) {
            PG8_LDB(B0, 0, 0); PG8_LDB(B1, 0, 1); PG8_SCHED; PG8_LDA(At, 0, 0); PG8_STAGE(PG8_SA(1, 1), a1 + hstep, voffA);
            PG8_WAIT_V(8); PG8_WAIT_L(0); PG8_BAR; PG8_MMA(0, 0, At, B0); PG8_MMA(0, 1, At, B1); PG8_BAR; PG8_SCHED;
            PG8_LDA(At, 0, 1); PG8_STAGE(PG8_SB(0, 0), b2, voffB); PG8_STAGE(PG8_SB(0, 1), b2 + hstep, voffB); PG8_STAGE(PG8_SA(0, 0), a2, voffA);
            PG8_WAIT_V(8); PG8_WAIT_L(0); PG8_BAR; PG8_MMA(1, 0, At, B0); PG8_MMA(1, 1, At, B1); PG8_BAR; PG8_SCHED;
            PG8_LDB(B0, 1, 0); PG8_LDB(B1, 1, 1); PG8_SCHED; PG8_LDA(At, 1, 0); PG8_STAGE(PG8_SA(0, 1), a2 + hstep, voffA);
            PG8_WAIT_V(8); PG8_WAIT_L(0); PG8_BAR; PG8_MMA(0, 0, At, B0); PG8_MMA(0, 1, At, B1); PG8_BAR; PG8_SCHED;
            PG8_LDA(At, 1, 1); PG8_STAGE(PG8_SB(1, 0), b3, voffB); PG8_STAGE(PG8_SB(1, 1), b3 + hstep, voffB); PG8_STAGE(PG8_SA(1, 0), a3, voffA);
            PG8_WAIT_V(8); PG8_WAIT_L(0); PG8_BAR; PG8_MMA(1, 0, At, B0); PG8_MMA(1, 1, At, B1); PG8_BAR; PG8_SCHED;
            } else {
            PG8_LDB(B0, 0, 0); PG8_SCHED; PG8_LDA(At, 0, 0); PG8_STAGE(PG8_SA(1, 1), a1 + hstep, voffA);
            PG8_WAIT_L(8); PG8_BAR; PG8_WAIT_L(0); PG8_MMA(0, 0, At, B0); PG8_BAR; PG8_SCHED;
            PG8_LDB(B1, 0, 1); PG8_STAGE(PG8_SB(0, 0), b2, voffB);
            PG8_BAR; PG8_WAIT_L(0); PG8_MMA(0, 1, At, B1); PG8_BAR;
            PG8_LDA(At, 0, 1); PG8_STAGE(PG8_SA(0, 0), a2, voffA);
            PG8_BAR; PG8_WAIT_L(0); PG8_MMA(1, 0, At, B0); PG8_BAR; PG8_SCHED;
            PG8_STAGE(PG8_SB(0, 1), b2 + hstep, voffB);
            PG8_WAIT_V(6); PG8_BAR; PG8_MMA(1, 1, At, B1); PG8_BAR;
            PG8_LDB(B0, 1, 0); PG8_SCHED; PG8_LDA(At, 1, 0); PG8_STAGE(PG8_SA(0, 1), a2 + hstep, voffA);
            PG8_WAIT_L(8); PG8_BAR; PG8_WAIT_L(0); PG8_MMA(0, 0, At, B0); PG8_BAR; PG8_SCHED;
            PG8_LDB(B1, 1, 1); PG8_STAGE(PG8_SB(1, 0), b3, voffB);
            PG8_BAR; PG8_WAIT_L(0); PG8_MMA(0, 1, At, B1); PG8_BAR;
            PG8_LDA(At, 1, 1); PG8_STAGE(PG8_SA(1, 0), a3, voffA);
            PG8_BAR; PG8_WAIT_L(0); PG8_MMA(1, 0, At, B0); PG8_BAR; PG8_SCHED;
            PG8_STAGE(PG8_SB(1, 1), b3 + hstep, voffB);
            PG8_WAIT_V(6); PG8_BAR; PG8_MMA(1, 1, At, B1); PG8_BAR;
            }
        }
        if constexpr (ALIGN_EPI) { if (wr == 0) PG8_BAR; }
        if constexpr (!Epi::AFTER_DRAIN) { E(acc, cur, wr, wc, fr, fq); S.done(cur); }
        if (!has_next) break;
#pragma unroll
        for (int a = 0; a < 2; ++a)
#pragma unroll
            for (int b = 0; b < 2; ++b)
#pragma unroll
                for (int m = 0; m < 4; ++m)
#pragma unroll
                    for (int n = 0; n < 2; ++n) acc[a][b][m][n] = (f32x4){0.f, 0.f, 0.f, 0.f};
        cur = nxt; cA = nA; cB = nB; ++ui;
        if constexpr (ALIGN_EPI) { if (wr == 1) PG8_BAR; }
    }
    PG8_WAIT_V(0);
    if constexpr (!ALIGN_EPI) { if (wr == 0) PG8_BAR; }
    PG8_BAR;
    if constexpr (Epi::AFTER_DRAIN) { E.fused(acc, cur, wr, wc, fr, fq, lds, wid, lane); S.done(cur); }
#undef PG8_SA
#undef PG8_SB
#undef PG8_STAGE
#undef PG8_LDA
#undef PG8_LDB
#undef PG8_MMA
#undef PG8_WAIT_V
#undef PG8_WAIT_L
#undef PG8_BAR
#undef PG8_SCHED
}
}
#ifndef EN
#define EN 255
#endif
#define LAS __attribute__((address_space(3)))
typedef unsigned short bf16_t;
typedef short bf16x8 __attribute__((ext_vector_type(8)));
typedef short s16x4 __attribute__((ext_vector_type(4)));
typedef float f32x4 __attribute__((ext_vector_type(4)));
typedef float f32x2 __attribute__((ext_vector_type(2)));
typedef unsigned u32x4 __attribute__((ext_vector_type(4)));
typedef unsigned u32x2 __attribute__((ext_vector_type(2)));
using pg8::cvt_pk_bf16; using pg8::sigmoidf_;

constexpr int M = 16384, D = 1024, SEQ = 8192, FF = 4096, NTHR = 512;
constexpr size_t MiB = 1u << 20;
constexpr size_t WS_ROWSQ = 1 * MiB, WS_ROPEC = 2 * MiB, WS_ROPES = 2 * MiB + 256 * 1024, WS_SPW = 2 * MiB + 512 * 1024;
constexpr size_t WS_W1 = 4 * MiB  , WS_W2 = 36 * MiB  , WS_ABIN = 68 * MiB  , WS_ABOUT = 76 * MiB  , WS_QKV = 80 * MiB  , WS_COUT = 92 * MiB  ;
constexpr size_t WS_XB = 96 * MiB, WS_BIG = 128 * MiB, WS_END = 256 * MiB;
constexpr size_t WS_UV = WS_BIG, WS_GB = WS_BIG + 32 * MiB, WS_CAT = WS_BIG + 48 * MiB;
constexpr size_t WS_Q = WS_BIG, WS_K = WS_BIG + 32 * MiB, WS_V = WS_BIG + 64 * MiB, WS_O = WS_BIG + 96 * MiB;
#ifndef WG_G1
#define WG_G1 1
#endif
#ifndef WG_G2
#define WG_G2 2
#endif
#ifndef WG_G3
#define WG_G3 2
#endif
#ifndef WG_G4
#define WG_G4 2
#endif
constexpr int LDS_BYTES = 139264;

struct Args { const float* in[19]; float* out; unsigned char* ws; int coop, ph_lo, ph_hi, pad; };

__device__ __forceinline__ float wave_sum(float v) {
#pragma unroll
    for (int o = 1; o < 64; o <<= 1) v += __shfl_xor(v, o);
    return v;
}
__device__ __forceinline__ float bf_lo(unsigned w) { return __uint_as_float(w << 16); }
__device__ __forceinline__ float bf_hi(unsigned w) { return __uint_as_float(w & 0xffff0000u); }

template <int MODE> __device__ __forceinline__ int rowmap(int n) {
    if (MODE == 1) {
        if (n < 1024) return n; const int j = (n - 1024) & 511, gate = (n - 1024) >> 9; return 1024 + 256 * (j >> 7) + 128 * gate + (j & 127);
    } else if (MODE == 2) {
        if (n >= 2048) return n; const int base = n & ~1023, r = n & 1023, head = r >> 6, d = r & 63; return base + 256 * (head >> 2) + 128 * (d >> 5) + 32 * (head & 3) + (d & 31);
    }
    return n;
}
template <int MODE> __device__ __forceinline__ void p0_transpose_item(const float* W, int K, int N, bf16_t* WT, const float* gk, LAS float* scr, int item, int lane) {
    const int nblk = N / 64, kb = item / nblk, nb = item % nblk, k0 = 64 * kb, n0 = 64 * nb, l15 = lane & 15, l4 = lane >> 4;
    f32x4 v[16];
#pragma unroll
    for (int i = 0; i < 16; ++i) v[i] = __builtin_nontemporal_load((const f32x4*)(W + (size_t)(k0 + 4 * i + l4) * N + n0 + 4 * l15));
    if (gk) {
#pragma unroll
        for (int i = 0; i < 16; ++i) v[i] = v[i] * gk[k0 + 4 * i + l4];
    }
#pragma unroll
    for (int i = 0; i < 16; ++i) { const int kk = 4 * i + l4; *(LAS f32x4*)(scr + kk * 64 + ((4 * l15) ^ (8 * (kk >> 3)))) = v[i]; }
    asm volatile("s_waitcnt lgkmcnt(0)" ::: "memory");
    const int c = lane & 7, nq = lane >> 3;
#pragma unroll
    for (int j = 0; j < 8; ++j) { const int n = nq + 8 * j; const LAS float* sp = scr + (8 * c) * 64 + (n ^ (8 * c));
        u32x4 o; o.x = cvt_pk_bf16(sp[0 * 64], sp[1 * 64]); o.y = cvt_pk_bf16(sp[2 * 64], sp[3 * 64]); o.z = cvt_pk_bf16(sp[4 * 64], sp[5 * 64]); o.w = cvt_pk_bf16(sp[6 * 64], sp[7 * 64]);
        *(u32x4*)(WT + (size_t)rowmap<MODE>(n0 + n) * K + k0 + 8 * c) = o; }
    asm volatile("s_waitcnt lgkmcnt(0)" ::: "memory");
}
template <int MODE> __device__ __forceinline__ void p0_matrix(const float* W, int K, int N, bf16_t* WT, const float* gk, LAS float* scr, int gw, int NGW, int lane) {
    const int nitems = (K / 64) * (N / 64);
    for (int it = gw; it < nitems; it += NGW) p0_transpose_item<MODE>(W, K, N, WT, gk, scr, it, lane);
}
__device__ __forceinline__ void sincos_d(double a, float& c, float& s) {
    const double twopi = 6.283185307179586476925286766559, inv = 0.15915494309189533576888376337251;
    const double k = __builtin_rint(a * inv); const double r = (a - k * twopi) * 0.25, r2 = r * r;
    double sn = 1.0, cs = 1.0;
    sn = r * (1.0 + r2 * (-1.0 / 6 + r2 * (1.0 / 120 + r2 * (-1.0 / 5040 + r2 * (1.0 / 362880 + r2 * (-1.0 / 39916800 + r2 * (1.0 / 6227020800.0 + r2 * (-1.0 / 1307674368000.0))))))));
    cs = 1.0 + r2 * (-0.5 + r2 * (1.0 / 24 + r2 * (-1.0 / 720 + r2 * (1.0 / 40320 + r2 * (-1.0 / 3628800 + r2 * (1.0 / 479001600.0 + r2 * (-1.0 / 87178291200.0 + r2 * (1.0 / 20922789888000.0))))))));
    double s2 = 2.0 * sn * cs, c2 = cs * cs - sn * sn; const double s4 = 2.0 * s2 * c2, c4 = c2 * c2 - s2 * s2;
    c = (float)c4; s = (float)s4;
}
__device__ __forceinline__ void p0_prologue(const Args& A, LAS unsigned char* lds, int tid, int lane, int wave) {
    unsigned char* ws = A.ws;
    LAS float* scr = (LAS float*)(lds + wave * 16384);
    const int gw = blockIdx.x * 8 + wave, NGW = gridDim.x * 8;
    const float* mixg = A.in[1]; const float* mlpg = A.in[2];
    for (int it = gw; it < 8192 + 2 * 1792; it += NGW) {
        int r = it;
        if (r < 4096) { const int l = r >> 10; p0_transpose_item<0>(A.in[3] + (size_t)l * D * FF, D, FF, (bf16_t*)(ws + WS_W1 + l * 8 * MiB), mlpg + l * D, scr, r & 1023, lane); continue; }
        r -= 4096;
        if (r < 4096) { const int l = r >> 10; p0_transpose_item<0>(A.in[4] + (size_t)l * D * FF, FF, D, (bf16_t*)(ws + WS_W2 + l * 8 * MiB), nullptr, scr, r & 1023, lane); continue; }
        r -= 4096;
        const int i = r >= 1792 ? 1 : 0; r -= i * 1792;
        if (r < 512) { p0_transpose_item<1>(A.in[5] + (size_t)i * D * 2048, D, 2048, (bf16_t*)(ws + WS_ABIN + i * 4 * MiB), mixg + (2 * i) * D, scr, r, lane); continue; }
        r -= 512;
        if (r < 256) { p0_transpose_item<0>(A.in[14] + (size_t)i * D * D, D, D, (bf16_t*)(ws + WS_ABOUT + i * 2 * MiB), nullptr, scr, r, lane); continue; }
        r -= 256;
        if (r < 768) { p0_transpose_item<2>(A.in[15] + (size_t)i * D * 3072, D, 3072, (bf16_t*)(ws + WS_QKV + i * 6 * MiB), mixg + (2 * i + 1) * D, scr, r, lane); continue; }
        r -= 768;
        p0_transpose_item<0>(A.in[18] + (size_t)i * D * D, D, D, (bf16_t*)(ws + WS_COUT + i * 2 * MiB), nullptr, scr, r, lane);
    }
    { const float* sw = A.in[6]; bf16_t* o = (bf16_t*)(ws + WS_SPW); const int gt = blockIdx.x * NTHR + tid, NT = gridDim.x * NTHR;
      for (int e = gt; e < 2 * 8 * 128 * 128 / 2; e += NT) { const f32x2 v = *(const f32x2*)(sw + 2 * (size_t)e); ((unsigned*)o)[e] = cvt_pk_bf16(v[0], v[1]); } }
    { float* rc = (float*)(ws + WS_ROPEC); float* rsn = (float*)(ws + WS_ROPES); const int gt = blockIdx.x * NTHR + tid, NT = gridDim.x * NTHR;
      for (int e = gt; e < SEQ * 8; e += NT) { const int pos = e >> 3, i = e & 7;
          const float f = i == 0 ? 1.0f : i == 1 ? 0.1939227432012558f : i == 2 ? 0.03760603070259094f : i == 3 ? 0.007292664609849453f : i == 4 ? 0.0014142135623842478f : i == 5 ? 0.00027424818836152554f : i == 6 ? 5.3182957344688475e-05f : 1.0313385246263351e-05f;
          const float ang = (float)pos * f; float c, s; sincos_d((double)ang, c, s); rc[e] = c; rsn[e] = s; } }
    { const float* x = A.in[0]; bf16_t* xb = (bf16_t*)(ws + WS_XB); float* rowsq = (float*)(ws + WS_ROWSQ);
      for (int m = gw; m < M; m += NGW) {
          const f32x4* xr = (const f32x4*)(x + (size_t)m * D) + lane; f32x4 v[4]; float s = 0.f;
#pragma unroll
          for (int j = 0; j < 4; ++j) { v[j] = __builtin_nontemporal_load(xr + 64 * j); s += (v[j][0] * v[j][0] + v[j][1] * v[j][1]) + (v[j][2] * v[j][2] + v[j][3] * v[j][3]); }
          s = wave_sum(s);
          u32x2* o = (u32x2*)(xb + (size_t)m * D) + lane;
#pragma unroll
          for (int j = 0; j < 4; ++j) { u32x2 w; w.x = cvt_pk_bf16(v[j][0], v[j][1]); w.y = cvt_pk_bf16(v[j][2], v[j][3]); o[64 * j] = w; }
          if (lane < 16) rowsq[(size_t)m * 16 + lane] = lane == 0 ? s : 0.f;
      } }
}

template <int CTRL> __device__ __forceinline__ float dppx(float v) { return __builtin_bit_cast(float, __builtin_amdgcn_update_dpp(0, __builtin_bit_cast(int, v), CTRL, 0xf, 0xf, true)); }
__device__ __forceinline__ float sum16(float v) {
    v += dppx<0xB1>(v); v += dppx<0x4E>(v); v += dppx<0x141>(v); v += dppx<0x140>(v); return v;
}
constexpr int VN_STRIDE = 672;
__device__ __forceinline__ bf16x8 tr_pair(const LAS unsigned char* p_lo, const LAS unsigned char* p_hi) {
    const s16x4 lo = __builtin_bit_cast(s16x4, __builtin_amdgcn_ds_read_tr16_b64_v4i16((LAS s16x4*)p_lo));
    const s16x4 hi = __builtin_bit_cast(s16x4, __builtin_amdgcn_ds_read_tr16_b64_v4i16((LAS s16x4*)p_hi));
    return (bf16x8){lo[0], lo[1], lo[2], lo[3], hi[0], hi[1], hi[2], hi[3]};
}
__device__ __forceinline__ void mixa_item(const Args& A, int li, int item, LAS unsigned char* lds, int tid, int lane, int wave) {
    const int chunk = item >> 1, gh = item & 1, row0 = chunk * 128;
    const bf16_t* UV = (const bf16_t*)(A.ws + WS_UV); bf16_t* CAT = (bf16_t*)(A.ws + WS_CAT);
    const float* vg = A.in[8] + li * 512; const float* vb = A.in[9] + li * 512; const float* spb = A.in[7] + li * 8 * 128;
    const bf16_t* spw = (const bf16_t*)(A.ws + WS_SPW) + (size_t)li * 8 * 128 * 128;
    {
        const int l15 = lane & 15, l4 = lane >> 4;
        f32x4 gA[2][2], bA[2][2];
#pragma unroll
        for (int i = 0; i < 2; ++i) { const int chn = (l15 + 16 * (2 * gh + i)) * 8;
            gA[i][0] = *(const f32x4*)(vg + chn); gA[i][1] = *(const f32x4*)(vg + chn + 4); bA[i][0] = *(const f32x4*)(vb + chn); bA[i][1] = *(const f32x4*)(vb + chn + 4); }
        u32x4 w[4][4];
#pragma unroll
        for (int it = 0; it < 4; ++it)
#pragma unroll
            for (int i = 0; i < 4; ++i) w[it][i] = *(const u32x4*)(UV + (size_t)(row0 + wave * 16 + it * 4 + l4) * 1024 + 512 + (l15 + 16 * i) * 8);
        u32x4 wsel[4][2];
#pragma unroll
        for (int it = 0; it < 4; ++it)
#pragma unroll
            for (int i = 0; i < 2; ++i) wsel[it][i] = *(const u32x4*)(UV + (size_t)(row0 + wave * 16 + it * 4 + l4) * 1024 + 512 + (l15 + 16 * (2 * gh + i)) * 8);
#pragma unroll
        for (int it = 0; it < 4; ++it) {
            const int q = wave * 16 + it * 4 + l4; float s1 = 0.f, s2 = 0.f;
#pragma unroll
            for (int i = 0; i < 4; ++i)
#pragma unroll
                for (int e = 0; e < 4; ++e) { const float a = bf_lo(w[it][i][e]), b = bf_hi(w[it][i][e]); s1 += a + b; s2 += a * a + b * b; }
            s1 = sum16(s1); s2 = sum16(s2);
            const float mean = s1 * (1.0f / 512.0f), rstd = __builtin_amdgcn_rsqf(fmaxf(s2 * (1.0f / 512.0f) - mean * mean, 0.f) + 1e-6f);
#pragma unroll
            for (int i = 0; i < 2; ++i) {
                const u32x4 ww = wsel[it][i]; u32x4 o;
#pragma unroll
                for (int e = 0; e < 4; ++e) { const int h2 = e >> 1, k2 = (e & 1) * 2;
                    const float a = (bf_lo(ww[e]) - mean) * rstd * gA[i][h2][k2] + bA[i][h2][k2], b = (bf_hi(ww[e]) - mean) * rstd * gA[i][h2][k2 + 1] + bA[i][h2][k2 + 1];
                    o[e] = cvt_pk_bf16(a, b); }
                *(LAS u32x4*)(lds + q * VN_STRIDE + (l15 + 16 * i) * 16) = o;
            }
        }
    }
    __syncthreads();
    const int gl = wave >> 1, ph = wave & 1, gg = gh * 4 + gl, g = lane >> 4, i16 = lane & 15;
    f32x4 acc[4][4];
#pragma unroll
    for (int a = 0; a < 4; ++a)
#pragma unroll
        for (int b = 0; b < 4; ++b) acc[a][b] = (f32x4){0.f, 0.f, 0.f, 0.f};
    const LAS unsigned char* trb = lds + (4 * g + (i16 >> 2)) * VN_STRIDE + (gl * 64 + 4 * (i16 & 3)) * 2;
    const bf16_t* wb = spw + ((size_t)gg * 128 + ph * 64 + i16) * 128 + 4 * g;
#pragma unroll
    for (int ks = 0; ks < 4; ++ks) {
        bf16x8 af[4], bfr[4];
#pragma unroll
        for (int cb = 0; cb < 4; ++cb) af[cb] = tr_pair(trb + (32 * ks) * VN_STRIDE + cb * 32, trb + (32 * ks + 16) * VN_STRIDE + cb * 32);
#pragma unroll
        for (int pb = 0; pb < 4; ++pb) { const s16x4 lo = *(const s16x4*)(wb + pb * 16 * 128 + 32 * ks), hi = *(const s16x4*)(wb + pb * 16 * 128 + 32 * ks + 16);
            bfr[pb] = (bf16x8){lo[0], lo[1], lo[2], lo[3], hi[0], hi[1], hi[2], hi[3]}; }
#pragma unroll
        for (int cb = 0; cb < 4; ++cb)
#pragma unroll
            for (int pb = 0; pb < 4; ++pb) acc[cb][pb] = __builtin_amdgcn_mfma_f32_16x16x32_bf16(af[cb], bfr[pb], acc[cb][pb], 0, 0, 0);
    }
    u32x2 uw[4][4]; float sbv[4];
#pragma unroll
    for (int pb = 0; pb < 4; ++pb) { const int p = ph * 64 + pb * 16 + i16; sbv[pb] = spb[gg * 128 + p];
#pragma unroll
        for (int cb = 0; cb < 4; ++cb) uw[pb][cb] = *(const u32x2*)(UV + (size_t)(row0 + p) * 1024 + gg * 64 + cb * 16 + 4 * g); }
    asm volatile("" ::: "memory");
#pragma unroll
    for (int pb = 0; pb < 4; ++pb) {
        const int p = ph * 64 + pb * 16 + i16;
#pragma unroll
        for (int cb = 0; cb < 4; ++cb) {
            const size_t off = (size_t)(row0 + p) * 1024 + gg * 64 + cb * 16 + 4 * g;
            const f32x4 sv = acc[cb][pb] + sbv[pb];
            u32x2 o; o.x = cvt_pk_bf16(bf_lo(uw[pb][cb].x) * sv[0], bf_hi(uw[pb][cb].x) * sv[1]); o.y = cvt_pk_bf16(bf_lo(uw[pb][cb].y) * sv[2], bf_hi(uw[pb][cb].y) * sv[3]);
            *(u32x2*)(CAT + off) = o;
        }
    }
    __syncthreads();
}
constexpr int CV_STRIDE = 516;
constexpr int GT_BYTES = 62 * 1024;
__device__ __forceinline__ void mixb_item(const Args& A, int li, int item, LAS unsigned char* lds, int tid, int lane, int wave) {
    const int row0 = item * 32, bb = row0 >> 13, pos0 = row0 & 8191;
    const bf16_t* Gb = (const bf16_t*)(A.ws + WS_GB); bf16_t* CAT = (bf16_t*)(A.ws + WS_CAT);
    const float* cw = A.in[10] + (size_t)li * 31 * 512; const float* cb = A.in[11] + li * 512; const float* ng = A.in[12] + li * 512; const float* nb = A.in[13] + li * 512;
    LAS float* cv = (LAS float*)(lds + 65536);
    {
        u32x4 st[8];
#pragma unroll
        for (int i = 0; i < 8; ++i) { const int idx = tid + NTHR * i, row = idx >> 6, ch = idx & 63, pos = pos0 - 15 + row; const bool ok = idx < 62 * 64 && pos >= 0 && pos < SEQ;
            st[i] = ok ? *(const u32x4*)(Gb + ((size_t)bb * SEQ + (ok ? pos : pos0)) * 512 + ch * 8) : (u32x4){0u, 0u, 0u, 0u}; }
#pragma unroll
        for (int i = 0; i < 8; ++i) { const int idx = tid + NTHR * i; if (idx < 62 * 64) *(LAS u32x4*)(lds + idx * 16) = st[i]; }
    }
    const int cp = tid & 255, tg = wave >> 2;
    const f32x2 bias = *(const f32x2*)(cb + 2 * cp);
    __syncthreads();
#pragma unroll 1
    for (int sb = 0; sb < 2; ++sb) {
        const int t0 = tg * 16 + sb * 8;
        float a0[8], a1[8];
#pragma unroll
        for (int t = 0; t < 8; ++t) { a0[t] = bias[0]; a1[t] = bias[1]; }
#pragma unroll 1
        for (int jc = 0; jc < 4; ++jc) {
            const LAS unsigned* ip = (const LAS unsigned*)(lds + (t0 + jc * 8) * 1024) + cp;
            unsigned in[15]; f32x2 w[8];
#pragma unroll
            for (int jj = 0; jj < 8; ++jj) { const int j = jc * 8 + jj; const f32x2 wv = *(const f32x2*)(cw + (j < 31 ? j : 30) * 512 + 2 * cp); w[jj] = j < 31 ? wv : (f32x2){0.f, 0.f}; }
#pragma unroll
            for (int k = 0; k < 15; ++k) in[k] = ip[k * 256];
#pragma unroll
            for (int t = 0; t < 8; ++t)
#pragma unroll
                for (int jj = 0; jj < 8; ++jj) { a0[t] += bf_lo(in[t + jj]) * w[jj][0]; a1[t] += bf_hi(in[t + jj]) * w[jj][1]; }
        }
#pragma unroll
        for (int t = 0; t < 8; ++t) *(LAS f32x2*)(cv + (t0 + t) * CV_STRIDE + 2 * cp) = (f32x2){a0[t], a1[t]};
    }
    __syncthreads();
    {
        const int l15 = lane & 15, t = wave * 4 + (lane >> 4);
        f32x4 v[8]; float s1 = 0.f, s2 = 0.f;
#pragma unroll
        for (int i = 0; i < 8; ++i) { v[i] = *(const LAS f32x4*)(cv + t * CV_STRIDE + (l15 + 16 * i) * 4); s1 += (v[i][0] + v[i][1]) + (v[i][2] + v[i][3]); s2 += (v[i][0] * v[i][0] + v[i][1] * v[i][1]) + (v[i][2] * v[i][2] + v[i][3] * v[i][3]); }
        s1 = sum16(s1); s2 = sum16(s2);
        const float mean = s1 * (1.0f / 512.0f), rstd = __builtin_amdgcn_rsqf(fmaxf(s2 * (1.0f / 512.0f) - mean * mean, 0.f) + 1e-6f);
        f32x4 gq[8], bq[8];
#pragma unroll
        for (int i = 0; i < 8; ++i) { const int c0 = (l15 + 16 * i) * 4; gq[i] = *(const f32x4*)(ng + c0); bq[i] = *(const f32x4*)(nb + c0); }
        asm volatile("" ::: "memory");
#pragma unroll
        for (int i = 0; i < 8; ++i) { const int c0 = (l15 + 16 * i) * 4; const f32x4 g4 = gq[i], b4 = bq[i]; f32x4 y = (v[i] - mean) * rstd * g4 + b4;
#pragma unroll
            for (int e = 0; e < 4; ++e) y[e] = y[e] * sigmoidf_(y[e]);
            u32x2 o; o.x = cvt_pk_bf16(y[0], y[1]); o.y = cvt_pk_bf16(y[2], y[3]);
            *(u32x2*)(CAT + (size_t)(row0 + t) * 1024 + 512 + c0) = o; }
    }
    __syncthreads();
}
constexpr int OA_STRIDE = 68;
constexpr int OB_STRIDE = 144;
constexpr int AT_ML = 512 * OB_STRIDE;
constexpr int AT_VST = AT_ML + 4096;
constexpr int VS_STRIDE = 160;
struct AtTask { int bh, pos0, dsh, L, r, lq0, qoff; };
__device__ __forceinline__ AtTask at_task(int item, int i, int wave) {
    AtTask T; const int span = item & 31; T.bh = item >> 5; T.pos0 = span * 256;
    const int pat = i >> 1, t = wave + 8 * (i & 1);
    T.dsh = 2 * pat; T.L = SEQ >> T.dsh;
    if (pat == 0) { T.r = 0; T.lq0 = T.pos0 + 16 * t; T.qoff = 16 * t; }
    else if (pat == 1) { T.r = t >> 2; T.lq0 = (T.pos0 >> 2) + 16 * (t & 3); T.qoff = 64 * (t & 3) + T.r; }
    else { T.r = t; T.lq0 = T.pos0 >> 4; T.qoff = T.r; }
    return T;
}
__device__ __forceinline__ void at_load_qk(const Args& A, const AtTask& T, int q16, int g, bf16x8 (&kf)[18], bf16x8 (&qf)[2]) {
    const size_t hb = ((size_t)(T.bh >> 4) * SEQ * 1024 + (T.bh & 15) * 64) * 2;
    const char* Qb = (const char*)(A.ws + WS_Q) + hb; const char* Kb = (const char*)(A.ws + WS_K) + hb;
    const unsigned qo = (unsigned)(((T.lq0 + q16) << T.dsh) + T.r) * 2048u + 16u * g;
    qf[0] = *(const bf16x8*)(Qb + qo); qf[1] = *(const bf16x8*)(Qb + qo + 64);
#pragma unroll
    for (int tile = 0; tile < 9; ++tile) {
        int lk = T.lq0 - 64 + 16 * tile + q16; lk = lk < 0 ? 0 : (lk > T.L - 1 ? T.L - 1 : lk);
        const unsigned ko = (unsigned)((lk << T.dsh) + T.r) * 2048u + 16u * g;
        kf[2 * tile] = *(const bf16x8*)(Kb + ko); kf[2 * tile + 1] = *(const bf16x8*)(Kb + ko + 64);
    }
}
template <int I0, int I1, int NR> __device__ __forceinline__ void at_load_v(const Args& A, const AtTask& T, int lane, u32x4 (&vr)[NR]) {
    const char* Vb = (const char*)(A.ws + WS_V) + ((size_t)(T.bh >> 4) * SEQ * 1024 + (T.bh & 15) * 64) * 2;
#pragma unroll
    for (int idx = I0; idx < I1; ++idx) { const int row = 8 * idx + (lane >> 3);
        int lk = T.lq0 - 64 + row; lk = lk < 0 ? 0 : (lk > T.L - 1 ? T.L - 1 : lk);
        vr[idx - I0] = *(const u32x4*)(Vb + ((unsigned)((lk << T.dsh) + T.r) * 2048u + 16u * (lane & 7))); }
}
typedef float f32x16 __attribute__((ext_vector_type(16)));
struct At32 { int bh, dsh, r, lq0, qoff, mode; };
__device__ __forceinline__ void at32_load_qk(const Args& A, const At32& T, int lane, bf16x8 (&qf)[4], bf16x8 (&kf)[5][4]) {
    const int L = SEQ >> T.dsh, q32 = lane & 31, h = lane >> 5, lk0 = T.lq0 - 64;
    const size_t hb = ((size_t)(T.bh >> 4) * SEQ * 1024 + (T.bh & 15) * 64) * 2;
    const char* Qb = (const char*)(A.ws + WS_Q) + hb; const char* Kb = (const char*)(A.ws + WS_K) + hb;
    const unsigned qo = (unsigned)(((T.lq0 + q32) << T.dsh) + T.r) * 2048u + 16u * h;
#pragma unroll
    for (int ds = 0; ds < 4; ++ds) qf[ds] = *(const bf16x8*)(Qb + qo + 32 * ds);
#pragma unroll
    for (int tile = 0; tile < 5; ++tile) { int lk = lk0 + 32 * tile + q32; lk = lk < 0 ? 0 : (lk > L - 1 ? L - 1 : lk);
        const unsigned ko = (unsigned)((lk << T.dsh) + T.r) * 2048u + 16u * h;
#pragma unroll
        for (int ds = 0; ds < 4; ++ds) kf[tile][ds] = *(const bf16x8*)(Kb + ko + 32 * ds); }
}
__device__ __forceinline__ void at_task32(const Args& A, const At32& T, const At32& Tn, bf16x8 (&qf)[4], bf16x8 (&kf)[5][4], LAS unsigned char* lds, LAS unsigned char* vst, int lane) {
    const int bh = T.bh, dsh = T.dsh, r = T.r, lq0 = T.lq0, qoff = T.qoff, mode = T.mode;
    LAS float* ML = (LAS float*)(lds + AT_ML);
    const int L = SEQ >> dsh, q32 = lane & 31, h = lane >> 5, lk0 = lq0 - 64;
    const size_t hb = ((size_t)(bh >> 4) * SEQ * 1024 + (bh & 15) * 64) * 2;
    const char* Vb = (const char*)(A.ws + WS_V) + hb;
    f32x16 s[5];
#define AT32_LOADK(t0, t1) do { _Pragma("unroll") for (int tile = (t0); tile < (t1); ++tile) { int lk = lk0 + 32 * tile + q32; lk = lk < 0 ? 0 : (lk > L - 1 ? L - 1 : lk); \
        const unsigned ko = (unsigned)((lk << dsh) + r) * 2048u + 16u * h; _Pragma("unroll") for (int ds = 0; ds < 4; ++ds) kf[tile][ds] = *(const bf16x8*)(Kb + ko + 32 * ds); } } while (0)
#define AT32_QK(t0, t1) do { _Pragma("unroll") for (int tile = (t0); tile < (t1); ++tile) { f32x16 z; _Pragma("unroll") for (int e = 0; e < 16; ++e) z[e] = 0.f; \
        _Pragma("unroll") for (int ds = 0; ds < 4; ++ds) z = __builtin_amdgcn_mfma_f32_32x32x16_bf16(kf[tile][ds], qf[ds], z, 0, 0, 0); s[tile] = z; } } while (0)
    AT32_QK(0, 3);
    __builtin_amdgcn_sched_barrier(0);
    AT32_QK(3, 5);
    __builtin_amdgcn_sched_barrier(0);
#undef AT32_LOADK
#undef AT32_QK
#pragma unroll
    for (int e = 0; e < 16; ++e) { const int cr = (e & 3) + 8 * (e >> 2) + 4 * h; if (cr - q32 < 0) s[0][e] = -1e30f; if (128 + cr - q32 > 128) s[4][e] = -1e30f; }
    if (lk0 < 0 || lk0 + 159 >= L) {
#pragma unroll
        for (int tile = 0; tile < 5; ++tile)
#pragma unroll
            for (int e = 0; e < 16; ++e) { const int lk = lk0 + 32 * tile + (e & 3) + 8 * (e >> 2) + 4 * h; if (lk < 0 || lk >= L) s[tile][e] = -1e30f; }
    }
    float mx = -1e30f;
#pragma unroll
    for (int tile = 0; tile < 5; ++tile)
#pragma unroll
        for (int e = 0; e < 16; ++e) mx = fmaxf(mx, s[tile][e]);
    { auto rr = __builtin_amdgcn_permlane32_swap(__float_as_uint(mx), __float_as_uint(mx), false, false); mx = fmaxf(__uint_as_float(rr[0]), __uint_as_float(rr[1])); }
    float lsum = 0.f;
#pragma unroll
    for (int tile = 0; tile < 5; ++tile)
#pragma unroll
        for (int e = 0; e < 16; ++e) { const float p = __builtin_amdgcn_exp2f(s[tile][e] - mx); s[tile][e] = p; lsum += p; }
    { auto rr = __builtin_amdgcn_permlane32_swap(__float_as_uint(lsum), __float_as_uint(lsum), false, false); lsum = __uint_as_float(rr[0]) + __uint_as_float(rr[1]); }
    __builtin_amdgcn_sched_barrier(0);
    u32x4 vr[8];
#pragma unroll
    for (int idx = 0; idx < 8; ++idx) { const int row = 8 * idx + (lane >> 3); int lk = lk0 + row; lk = lk < 0 ? 0 : (lk > L - 1 ? L - 1 : lk);
        vr[idx] = *(const u32x4*)(Vb + ((unsigned)((lk << dsh) + r) * 2048u + 16u * (lane & 7))); }
    f32x16 o[2];
#pragma unroll
    for (int db = 0; db < 2; ++db)
#pragma unroll
        for (int e = 0; e < 16; ++e) o[db][e] = 0.f;
    const int i16 = lane & 15;
    const LAS unsigned char* trb = vst + (4 * h + (i16 >> 2)) * VS_STRIDE + (((lane >> 4) & 1) * 16 + 4 * (i16 & 3)) * 2;
#pragma unroll
    for (int tile = 0; tile < 5; ++tile) {
#pragma unroll
        for (int it = 0; it < 4; ++it) { const int idx = it * 64 + lane, row = idx >> 3, ch = idx & 7; *(LAS u32x4*)(vst + row * VS_STRIDE + ch * 16) = vr[(tile & 1) * 4 + it]; }
        if (tile < 3) {
#pragma unroll
            for (int it = 0; it < 4; ++it) { const int row = 32 * (tile + 2) + 8 * it + (lane >> 3); int lk = lk0 + row; lk = lk < 0 ? 0 : (lk > L - 1 ? L - 1 : lk);
                vr[(tile & 1) * 4 + it] = *(const u32x4*)(Vb + ((unsigned)((lk << dsh) + r) * 2048u + 16u * (lane & 7))); }
        }
        bf16x8 pf[2];
#pragma unroll
        for (int ks = 0; ks < 2; ++ks) { u32x4 pw; pw.x = cvt_pk_bf16(s[tile][8 * ks + 0], s[tile][8 * ks + 1]); pw.y = cvt_pk_bf16(s[tile][8 * ks + 2], s[tile][8 * ks + 3]);
            pw.z = cvt_pk_bf16(s[tile][8 * ks + 4], s[tile][8 * ks + 5]); pw.w = cvt_pk_bf16(s[tile][8 * ks + 6], s[tile][8 * ks + 7]); pf[ks] = __builtin_bit_cast(bf16x8, pw); }
        asm volatile("s_waitcnt lgkmcnt(0)" ::: "memory");
#pragma unroll
        for (int ks = 0; ks < 2; ++ks)
#pragma unroll
            for (int db = 0; db < 2; ++db) { const bf16x8 af = tr_pair(trb + (16 * ks) * VS_STRIDE + db * 64, trb + (16 * ks + 8) * VS_STRIDE + db * 64);
                o[db] = __builtin_amdgcn_mfma_f32_32x32x16_bf16(af, pf[ks], o[db], 0, 0, 0); }
        asm volatile("s_waitcnt lgkmcnt(0)" ::: "memory");
    }
    asm volatile("" ::: "memory");
    at32_load_qk(A, Tn, lane, qf, kf);
    asm volatile("" ::: "memory");
    const int ql = qoff + (q32 << dsh);
    LAS unsigned char* orow = lds + ql * OB_STRIDE + 8 * h;
    float ca = 0.f, cbb = 1.f, mn = mx, ln = lsum;
    if (mode != 0) { const f32x2 ml = *(const LAS f32x2*)(ML + 2 * ql); mn = fmaxf(ml[0], mx); ca = __builtin_amdgcn_exp2f(ml[0] - mn); cbb = __builtin_amdgcn_exp2f(mx - mn); ln = ca * ml[1] + cbb * lsum; }
    if (mode == 2) { const float inv = 1.0f / ln; ca *= inv; cbb *= inv; }
#pragma unroll
    for (int db = 0; db < 2; ++db) {
        u32x2 oldw[4];
#pragma unroll
        for (int rg = 0; rg < 4; ++rg) oldw[rg] = mode != 0 ? *(const LAS u32x2*)(orow + (32 * db + 8 * rg) * 2) : (u32x2){0u, 0u};
#pragma unroll
        for (int rg = 0; rg < 4; ++rg) { u32x2 w;
            w.x = cvt_pk_bf16(bf_lo(oldw[rg].x) * ca + o[db][4 * rg] * cbb, bf_hi(oldw[rg].x) * ca + o[db][4 * rg + 1] * cbb);
            w.y = cvt_pk_bf16(bf_lo(oldw[rg].y) * ca + o[db][4 * rg + 2] * cbb, bf_hi(oldw[rg].y) * ca + o[db][4 * rg + 3] * cbb);
            *(LAS u32x2*)(orow + (32 * db + 8 * rg) * 2) = w; }
        asm volatile("" ::: "memory");
    }
    if (mode != 2 && h == 0) *(LAS f32x2*)(ML + 2 * ql) = (f32x2){mn, ln};
}
__device__ __forceinline__ void at_task16_last(const Args& A, const AtTask& cur, LAS unsigned char* lds, LAS unsigned char* vst, int lane) {
    LAS float* Oacc = (LAS float*)lds; LAS float* ML = (LAS float*)(lds + AT_ML);
    const int q16 = lane & 15, g = lane >> 4;
    const LAS unsigned char* trb = vst + (4 * g + (q16 >> 2)) * VS_STRIDE + (4 * (q16 & 3)) * 2;
    bf16x8 kf[18], qf[2]; u32x4 vr[18];
    at_load_qk(A, cur, q16, g, kf, qf);
    f32x4 s[9];
#pragma unroll
    for (int tile = 0; tile < 9; ++tile) {
        f32x4 z = (f32x4){0.f, 0.f, 0.f, 0.f};
        z = __builtin_amdgcn_mfma_f32_16x16x32_bf16(kf[2 * tile], qf[0], z, 0, 0, 0);
        s[tile] = __builtin_amdgcn_mfma_f32_16x16x32_bf16(kf[2 * tile + 1], qf[1], z, 0, 0, 0);
    }
    at_load_v<0, 18, 18>(A, cur, lane, vr);
    const int lk0 = cur.lq0 - 64;
#pragma unroll
    for (int e = 0; e < 4; ++e) { if (4 * g + e - q16 < 0) s[0][e] = -1e30f; if (128 + 4 * g + e - q16 > 128) s[8][e] = -1e30f; }
    if (lk0 < 0 || lk0 + 143 >= cur.L) {
#pragma unroll
        for (int tile = 0; tile < 9; ++tile)
#pragma unroll
            for (int e = 0; e < 4; ++e) { const int lk = lk0 + 16 * tile + 4 * g + e; if (lk < 0 || lk >= cur.L) s[tile][e] = -1e30f; }
    }
    float mx = -1e30f;
#pragma unroll
    for (int tile = 0; tile < 9; ++tile) mx = fmaxf(fmaxf(mx, fmaxf(s[tile][0], s[tile][1])), fmaxf(s[tile][2], s[tile][3]));
    mx = fmaxf(mx, __shfl_xor(mx, 16)); mx = fmaxf(mx, __shfl_xor(mx, 32));
    float lsum = 0.f;
#pragma unroll
    for (int tile = 0; tile < 9; ++tile)
#pragma unroll
        for (int e = 0; e < 4; ++e) { const float p = __builtin_amdgcn_exp2f(s[tile][e] - mx); s[tile][e] = p; lsum += p; }
    lsum += __shfl_xor(lsum, 16); lsum += __shfl_xor(lsum, 32);
    bf16x8 pf[5];
#pragma unroll
    for (int ks = 0; ks < 5; ++ks) { const f32x4 p0 = s[2 * ks]; f32x4 p1 = (f32x4){0.f, 0.f, 0.f, 0.f}; if (2 * ks + 1 < 9) p1 = s[2 * ks + 1 < 9 ? 2 * ks + 1 : 8];
        u32x4 pw; pw.x = cvt_pk_bf16(p0[0], p0[1]); pw.y = cvt_pk_bf16(p0[2], p0[3]); pw.z = cvt_pk_bf16(p1[0], p1[1]); pw.w = cvt_pk_bf16(p1[2], p1[3]); pf[ks] = __builtin_bit_cast(bf16x8, pw); }
    f32x4 o[4];
#pragma unroll
    for (int db = 0; db < 4; ++db) o[db] = (f32x4){0.f, 0.f, 0.f, 0.f};
#pragma unroll
    for (int ks = 0; ks < 5; ++ks) {
#pragma unroll
        for (int it = 0; it < 4; ++it) { if (ks * 4 + it < 18) { const int idx = it * 64 + lane, row = idx >> 3, ch = idx & 7; *(LAS u32x4*)(vst + row * VS_STRIDE + ch * 16) = vr[ks * 4 + it < 18 ? ks * 4 + it : 0]; } }
        asm volatile("s_waitcnt lgkmcnt(0)" ::: "memory");
#pragma unroll
        for (int db = 0; db < 4; ++db) { const bf16x8 af = tr_pair(trb + db * 32, trb + 16 * VS_STRIDE + db * 32); o[db] = __builtin_amdgcn_mfma_f32_16x16x32_bf16(af, pf[ks], o[db], 0, 0, 0); }
        asm volatile("s_waitcnt lgkmcnt(0)" ::: "memory");
    }
    const int ql = cur.qoff + (q16 << cur.dsh);
    LAS float* orow = Oacc + ql * OA_STRIDE + 4 * g;
    const f32x2 ml = *(const LAS f32x2*)(ML + 2 * ql);
    const float mn = fmaxf(ml[0], mx), ca = __builtin_amdgcn_exp2f(ml[0] - mn), cbb = __builtin_amdgcn_exp2f(mx - mn), ln = ca * ml[1] + cbb * lsum;
    f32x4 on[4];
#pragma unroll
    for (int db = 0; db < 4; ++db) on[db] = *(const LAS f32x4*)(orow + 16 * db) * ca + o[db] * cbb;
    asm volatile("s_waitcnt lgkmcnt(0)" ::: "memory");
    const float inv = 1.0f / ln;
    LAS unsigned char* brow = (LAS unsigned char*)(Oacc + ql * OA_STRIDE);
#pragma unroll
    for (int db = 0; db < 4; ++db) { const f32x4 v = on[db] * inv; u32x2 w; w.x = cvt_pk_bf16(v[0], v[1]); w.y = cvt_pk_bf16(v[2], v[3]); *(LAS u32x2*)(brow + (16 * db + 4 * g) * 2) = w; }
}
__device__ __forceinline__ void attn_phase(const Args& A, LAS unsigned char* lds, int tid, int lane, int wave, int bx, int G) {
    LAS unsigned char* vst = lds + AT_VST + wave * (32 * VS_STRIDE);
    const bool xmap = (G == 256);
#define AT_ITEM(k) (xmap ? ((((bx & 7) * 4 + (((k) * 32 + (bx >> 3)) >> 4)) << 4) | (((k) * 32 + (bx >> 3)) & 15)) : (bx + (k) * G))
#define AT_VALID(k) (xmap ? ((k) < 2) : (bx + (k) * G < 512))
#define AT_TASK(T_, item_, i_) do { const int span_ = (item_) & 15, pos0_ = span_ * 512, pat_ = (i_) >> 1, t_ = wave + 8 * ((i_) & 1); (T_).bh = (item_) >> 4; (T_).mode = pat_; \
        if (pat_ == 0) { (T_).dsh = 0; (T_).r = 0; (T_).lq0 = pos0_ + 32 * t_; (T_).qoff = 32 * t_; } \
        else if (pat_ == 1) { (T_).dsh = 2; (T_).r = t_ >> 2; (T_).lq0 = (pos0_ >> 2) + 32 * (t_ & 3); (T_).qoff = 128 * (t_ & 3) + (t_ >> 2); } \
        else { (T_).dsh = 4; (T_).r = t_; (T_).lq0 = pos0_ >> 4; (T_).qoff = t_; } } while (0)
    if (!AT_VALID(0)) return;
    bf16x8 qf[4], kf[5][4];
    At32 cur; AT_TASK(cur, AT_ITEM(0), 0);
    at32_load_qk(A, cur, lane, qf, kf);
#pragma unroll 1
    for (int kstep = 0; AT_VALID(kstep); ++kstep) {
        const int item = AT_ITEM(kstep), span = item & 15, bh = item >> 4, pos0 = span * 512;
#pragma unroll 1
        for (int i = 0; i < 6; ++i) {
            At32 nxt;
            if (i < 5) { AT_TASK(nxt, item, i + 1); } else { const int ni = AT_VALID(kstep + 1) ? AT_ITEM(kstep + 1) : item; AT_TASK(nxt, ni, 0); }
            at_task32(A, cur, nxt, qf, kf, lds, vst, lane);
            cur = nxt;
            if (i & 1) asm volatile("s_waitcnt lgkmcnt(0)\n\ts_barrier" ::: "memory");
        }
        {
            bf16_t* Op = (bf16_t*)(A.ws + WS_O) + (size_t)(bh >> 4) * SEQ * 1024 + (bh & 15) * 64;
#pragma unroll
            for (int rd = 0; rd < 8; ++rd) { const int idx = rd * NTHR + tid, row = idx >> 3, ch = idx & 7;
                const u32x4 v = *(const LAS u32x4*)(lds + row * OB_STRIDE + ch * 16);
                *(u32x4*)(Op + (size_t)(pos0 + row) * 1024 + ch * 8) = v; }
        }
        asm volatile("s_waitcnt lgkmcnt(0)\n\ts_barrier" ::: "memory");
    }
#undef AT_TASK
}

#define XB_TMO      128
#define XB_XCNT(j)  (256  + 64 * (j))
#define XB_XSUB(j)  (1280 + 64 * (j))
#define XB_XGEN(j)  (2304 + 64 * (j))
#define XB_TOP      3328
#define XB_TOPGEN   3392
#define XCD_BAR_WORDS 3456
#define XB_SPIN_CAP (1u << 18)

__device__ __forceinline__ unsigned xb_ld(unsigned* p)              { return __hip_atomic_load(p, __ATOMIC_RELAXED, __HIP_MEMORY_SCOPE_AGENT); }
__device__ __forceinline__ unsigned xb_add(unsigned* p, unsigned v) { return __hip_atomic_fetch_add(p, v, __ATOMIC_RELAXED, __HIP_MEMORY_SCOPE_AGENT); }
__device__ __forceinline__ unsigned xb_xcc_id() { return (unsigned)__builtin_amdgcn_s_getreg((3 << 11) | 20) & 0xFu; }
#define XB_SPIN(cond, bar) do { unsigned _sp = 0; while (cond) { __builtin_amdgcn_s_sleep(1); \
    if ((++_sp & 255u) == 0u) { if (xb_ld(&(bar)[XB_TMO])) break; if (_sp > XB_SPIN_CAP) { atomicAdd(&(bar)[XB_TMO], 1u); break; } } } } while (0)

struct XcdBarrier {
    unsigned* bar; unsigned x;
    volatile LAS unsigned* st;
};

__device__ __forceinline__ XcdBarrier xcd_barrier_post(unsigned* bar, volatile LAS unsigned* st) {
    XcdBarrier b; b.bar = bar; b.x = xb_xcc_id(); b.st = st;
    if (threadIdx.x == 0) (void)xb_add(&bar[XB_XCNT(b.x)], 1u);
    return b;
}
__device__ __forceinline__ void xcd_barrier_complete(unsigned* bar, unsigned x, unsigned& nloc, unsigned& nx) {
    const unsigned G = gridDim.x * gridDim.y * gridDim.z;
    unsigned sum, cnt, mine, sp = 0u;
    for (;;) {
        sum = 0u; cnt = 0u; mine = 0u;
#pragma unroll
        for (unsigned j = 0; j < 16; ++j) { const unsigned c = xb_ld(&bar[XB_XCNT(j)]); sum += c; cnt += (c > 0u) ? 1u : 0u; mine = (j == x) ? c : mine; }
        if (sum == G) break;
        __builtin_amdgcn_s_sleep(1);
        if ((++sp & 255u) == 0u) { if (xb_ld(&bar[XB_TMO])) break; if (sp > XB_SPIN_CAP) { atomicAdd(&bar[XB_TMO], 1u); break; } }
    }
    nloc = mine > 0u ? mine : 1u; nx = cnt > 0u ? cnt : 1u;
}

__device__ __forceinline__ void xcd_barrier(const XcdBarrier& b) {
    asm volatile("s_waitcnt vmcnt(0)" ::: "memory");
    __syncthreads();
    if (threadIdx.x == 0) {
        unsigned* bar = b.bar;
        __builtin_amdgcn_s_waitcnt(0);
        unsigned nloc = b.st[0], nx = b.st[1];
        if (nloc == 0u) { xcd_barrier_complete(bar, b.x, nloc, nx); b.st[0] = nloc; b.st[1] = nx; }
        const unsigned old = xb_add(&bar[XB_XSUB(b.x)], 1u);
        const unsigned gen = old / nloc;
        if (old + 1u == (gen + 1u) * nloc) {
            __builtin_amdgcn_fence(__ATOMIC_RELEASE, "agent");
            asm volatile("s_waitcnt vmcnt(0)" ::: "memory");
            const unsigned og = xb_add(&bar[XB_TOP], 1u);
            const unsigned tg = og / nx;
            if (og + 1u == (tg + 1u) * nx) xb_add(&bar[XB_TOPGEN], 1u);
            else XB_SPIN(xb_ld(&bar[XB_TOPGEN]) == tg, bar);
            __builtin_amdgcn_fence(__ATOMIC_ACQUIRE, "agent");
            asm volatile("s_waitcnt vmcnt(0)" ::: "memory");
        } else {
            XB_SPIN(xb_ld(&bar[XB_TOPGEN]) == gen, bar);
            __builtin_amdgcn_fence(__ATOMIC_ACQUIRE, "agent");
            asm volatile("s_waitcnt vmcnt(0)" ::: "memory");
        }
    }
    __syncthreads();
}

__global__ void __launch_bounds__(NTHR, 2) mega_fwd(Args A) {
    extern __shared__ __attribute__((aligned(16))) unsigned char lds_raw[];
    LAS unsigned char* lds = (LAS unsigned char*)lds_raw;
    const int G = gridDim.x, bx = blockIdx.x;
    volatile LAS unsigned* bst = (volatile LAS unsigned*)(lds + LDS_BYTES - 16);
    if (threadIdx.x < 4) bst[threadIdx.x] = 0u;
    __syncthreads();
    XcdBarrier bar; bar.bar = (unsigned*)A.ws; bar.x = 0; bar.st = bst;
    if (A.coop) bar = xcd_barrier_post((unsigned*)A.ws, bst);
    int ph = 0;
#define PHASE_BEGIN if (ph >= A.ph_lo && ph < A.ph_hi) { int tid = threadIdx.x; asm volatile("" : "+v"(tid)); const int lane = tid & 63, wave = __builtin_amdgcn_readfirstlane(tid >> 6); unsigned char* ws = A.ws; asm volatile("" : "+s"(ws)); bf16_t* xb = (bf16_t*)(ws + WS_XB); float* rowsq = (float*)(ws + WS_ROWSQ);
#define PHASE_END   if (A.coop && ph + 1 < A.ph_hi) { if (A.pad == 0x7fffffff) cg::this_grid().sync();   xcd_barrier(bar); } } ++ph;
#ifndef REP_MASK
#define REP_MASK 0
#endif
#define REP_BEGIN(bit) for (int rep_ = 0; rep_ < (((REP_MASK) & (bit)) ? 2 : 1); ++rep_) { if (rep_) cg::this_grid().sync();
#define REP_END }
    PHASE_BEGIN
        REP_BEGIN(1)
#if EN & 1
 p0_prologue(A, lds, tid, lane, wave);
#endif
        REP_END
 PHASE_END
#pragma unroll 1
    for (int layer = 0; layer < 4; ++layer) {
        const int li = layer >> 1; const bool even = (layer & 1) == 0;
        PHASE_BEGIN
        REP_BEGIN(2)
#if EN & 2
        if (even) { pg8::Gemm g{xb, (const bf16_t*)(ws + WS_ABIN + li * 4 * MiB), M, 2048, D}; pg8::StaticOrder S; S.init(M, 2048, G, bx, WG_G1);
            pg8::EpiZ E{(bf16_t*)(ws + WS_UV), (bf16_t*)(ws + WS_GB), rowsq, (LAS float*)(lds + 131072)};
            pg8::gemm_phase<pg8::EpiZ, pg8::StaticOrder, true, true>(lds, g, S, E); }
#endif
#if EN & 4
        if (!even) { pg8::Gemm g{xb, (const bf16_t*)(ws + WS_QKV + li * 6 * MiB), M, 3072, D}; pg8::StaticOrder S; S.init(M, 3072, G, bx, WG_G1);
            pg8::EpiQKV E{(bf16_t*)(ws + WS_Q), (bf16_t*)(ws + WS_K), (bf16_t*)(ws + WS_V), rowsq, A.in[16] + li * 64, A.in[17] + li * 64, (const float*)(ws + WS_ROPEC), (const float*)(ws + WS_ROPES), (LAS float*)(lds + 131072)};
            pg8::gemm_phase<pg8::EpiQKV, pg8::StaticOrder, true, true>(lds, g, S, E); }
#endif
        REP_END
        PHASE_END
        PHASE_BEGIN
        REP_BEGIN(even ? 4 : 8)
#if EN & 8
        if (even) { for (int it = bx; it < 768; it += G) {
#ifndef NO_MIXA
 if (it < 256) { mixa_item(A, li, it, lds, tid, lane, wave);
#ifdef DUP_MIXA
 mixa_item(A, li, it, lds, tid, lane, wave);
#endif
 }
#endif
#ifndef NO_MIXB
 if (it >= 256) { mixb_item(A, li, it - 256, lds, tid, lane, wave);
#ifdef DUP_MIXB
 mixb_item(A, li, it - 256, lds, tid, lane, wave);
#endif
 }
#endif
 } }
#endif
#if EN & 16
        if (!even) { if (wave >= 4) __builtin_amdgcn_s_setprio(1);     attn_phase(A, lds, tid, lane, wave, bx, G); __builtin_amdgcn_s_setprio(0); }
#endif
        REP_END
        PHASE_END
        PHASE_BEGIN
#if EN & 32
        { pg8::Gemm g{(const bf16_t*)(ws + (even ? WS_CAT : WS_O)), (const bf16_t*)(ws + (even ? WS_ABOUT : WS_COUT) + li * 2 * MiB), M, D, D}; pg8::StaticOrder S; S.init(M, D, G, bx, WG_G2);
          pg8::EpiRes E{xb, rowsq, nullptr};
          pg8::gemm_phase<pg8::EpiRes, pg8::StaticOrder, true, true>(lds, g, S, E); }
#endif
        PHASE_END
        PHASE_BEGIN
        REP_BEGIN(16)
#if EN & 64
        { pg8::Gemm g{xb, (const bf16_t*)(ws + WS_W1 + layer * 8 * MiB), M, FF, D}; pg8::StaticOrder S; S.init(M, FF, G, bx, WG_G3);
          pg8::EpiW1 E{(bf16_t*)(ws + WS_BIG), rowsq, (LAS float*)(lds + 131072)};
          pg8::gemm_phase<pg8::EpiW1, pg8::StaticOrder, true, true>(lds, g, S, E); }
#endif
        REP_END
        PHASE_END
        PHASE_BEGIN
#if EN & 128
        { pg8::Gemm g{(const bf16_t*)(ws + WS_BIG), (const bf16_t*)(ws + WS_W2 + layer * 8 * MiB), M, D, FF}; pg8::StaticOrder S; S.init(M, D, G, bx, WG_G4);
          pg8::EpiRes E{xb, rowsq, layer == 3 ? A.out : nullptr};
          pg8::gemm_phase<pg8::EpiRes, pg8::StaticOrder, true, true>(lds, g, S, E); }
#endif
        PHASE_END
    }
}
constexpr int N_PHASES = 21;
#ifndef MK_MULTI
#define MK_MULTI 0
#endif
extern "C" void kernel_launch(void* const* d_in, const int* in_sizes, int n_in, void* d_out, int out_size, void* d_ws, size_t ws_size, hipStream_t stream) {
    static int grid = 0;
    if (grid == 0) {
        if (n_in != 19 || out_size != M * D || ws_size < WS_END) { fprintf(stderr, "kernel_launch: unexpected shapes n_in %d out %d ws %zu\n", n_in, out_size, ws_size); grid = -1; return; }
        int dev = 0, cus = 0, per_cu = 0;
        hipGetDevice(&dev); hipDeviceGetAttribute(&cus, hipDeviceAttributeMultiprocessorCount, dev);
        hipFuncSetAttribute((const void*)mega_fwd, hipFuncAttributeMaxDynamicSharedMemorySize, LDS_BYTES);
        hipOccupancyMaxActiveBlocksPerMultiprocessor(&per_cu, (const void*)mega_fwd, NTHR, LDS_BYTES);
        if (per_cu < 1) { fprintf(stderr, "kernel_launch: occupancy query says %d blocks per CU\n", per_cu); per_cu = 1; }
        (void)hipGetLastError();
        grid = cus * (per_cu > 1 ? 1 : per_cu);
        fprintf(stderr, "kernel_launch: grid %d (cus %d per_cu %d)\n", grid, cus, per_cu);
    }
    if (grid < 0) return;
    Args a{};
    for (int i = 0; i < 19; ++i) a.in[i] = (const float*)d_in[i];
    a.out = (float*)d_out; a.ws = (unsigned char*)d_ws;
#if MK_MULTI
    for (int p = 0; p < N_PHASES; ++p) { a.coop = 0; a.ph_lo = p; a.ph_hi = p + 1; hipLaunchKernelGGL(mega_fwd, dim3(grid), dim3(NTHR), LDS_BYTES, stream, a); }
#else
    hipMemsetAsync(d_ws, 0, 16384, stream);
    a.coop = 1; a.ph_lo = 0; a.ph_hi = N_PHASES;
    void* args[] = {&a};
    hipError_t e = hipLaunchCooperativeKernel((const void*)mega_fwd, dim3(grid), dim3(NTHR), args, LDS_BYTES, stream);
    if (e != hipSuccess) fprintf(stderr, "cooperative launch failed: %s (grid %d)\n", hipGetErrorString(e), grid);
#endif
}
```

```cpp
#include <hip/hip_runtime.h>
#include <hip/hip_cooperative_groups.h>
#include <cstdio>
#include <cstdint>
namespace cg = cooperative_groups;
namespace pg8 {
#define PG8_LAS __attribute__((address_space(3)))
typedef unsigned short bf16_t;
typedef short bf16x8 __attribute__((ext_vector_type(8)));
typedef float f32x4 __attribute__((ext_vector_type(4)));
typedef unsigned u32x4 __attribute__((ext_vector_type(4)));
constexpr int BM = 256, BK = 64, HALF = 128, HTB = HALF * BK * 2  , STAGE_BYTES = 8 * HTB, NXCD = 8, WGM = 8;

__host__ __device__ __forceinline__ int lds_byte(int r, int c) { const int st = (r >> 4) * 2 + (c >> 5), rr = r & 15, cc = c & 31, ob = rr * 64 + cc * 2; return st * 1024 + (ob ^ (((ob >> 9) & 1) << 5)); }
__host__ __device__ __forceinline__ void stage_rc(int b, int& R, int& C) { const int st = b / 1024, sb = b % 1024, swz = sb ^ (((sb >> 9) & 1) << 5); R = (st >> 1) * 16 + swz / 64; C = (st & 1) * 32 + (swz % 64) / 2; }
__host__ __device__ __forceinline__ int perm32(int rho) { const int n = rho >> 4, i = rho & 15; return 8 * (i >> 2) + 4 * n + (i & 3); }

struct Unit { int pm, pn; };
struct Gemm { const bf16_t* A; const bf16_t* Bt; int M, N, K; };

struct StaticOrder {
    int nM, nN, nwg, G, c, wgm;
    __host__ __device__ void init(int M, int N, int G_, int c_, int wgm_ = 2) { nM = M / BM; nN = N / BM; nwg = nM * nN; G = G_; c = c_; wgm = wgm_; }
    __host__ __device__ bool next(int i, Unit& u) const {
        const long L = (long)i * G + c; if (L >= nwg) return false;
        int wgid = (int)L; { const int q = nwg / NXCD, r = nwg % NXCD, xcd = wgid % NXCD, off = wgid / NXCD; wgid = (xcd < r ? xcd * (q + 1) : r * (q + 1) + (xcd - r) * q) + off; }
        const int nig = wgm * nN, gid = wgid / nig, fm = gid * wgm, gsz = (nM - fm) < wgm ? (nM - fm) : wgm;
        u.pm = fm + ((wgid % nig) % gsz); u.pn = (wgid % nig) / gsz; return true;
    }
    __device__ __forceinline__ void a_ready(const Unit&) const {}
    __device__ __forceinline__ void done(const Unit&) const {}
};

typedef unsigned u32x2 __attribute__((ext_vector_type(2)));
__device__ __forceinline__ unsigned cvt_pk_bf16(float lo, float hi) { unsigned r; asm volatile("v_cvt_pk_bf16_f32 %0, %1, %2" : "=v"(r) : "v"(lo), "v"(hi)); return r; }
__device__ __forceinline__ float row_rstd16(const float* rowsq, int row) {
    const f32x4* p = (const f32x4*)(rowsq + (size_t)row * 16);
    const f32x4 a = p[0], b = p[1], c = p[2], d = p[3];
    const float s = ((a[0] + a[1]) + (a[2] + a[3])) + ((b[0] + b[1]) + (b[2] + b[3])) + ((c[0] + c[1]) + (c[2] + c[3])) + ((d[0] + d[1]) + (d[2] + d[3]));
    return __builtin_amdgcn_rsqf(s * (1.0f / 1024.0f) + 1e-6f);
}
__device__ __forceinline__ float gelu_tanh(float x) {
    const float t = 0.7978845608028654f * (x + 0.044715f * x * x * x);
    const float e = __builtin_amdgcn_exp2f(-2.0f * 1.4426950408889634f * t);
    return x * __builtin_amdgcn_rcpf(1.0f + e);
}
__device__ __forceinline__ float sigmoidf_(float x) { return __builtin_amdgcn_rcpf(1.0f + __builtin_amdgcn_exp2f(-1.4426950408889634f * x)); }

struct EpiZ {
    static constexpr bool PERM = true, AFTER_DRAIN = false;
    bf16_t* UV; bf16_t* Gb; const float* rowsq; PG8_LAS float* tab;
    __device__ __forceinline__ void operator()(const f32x4 (&acc)[2][2][4][2], const Unit& u, int wr, int wc, int fr, int fq) const {
        const int row0 = u.pm * BM + wr * 64 + fr;
        PG8_LAS float* tb = tab + (wr * 4 + wc) * 128;
#pragma unroll
        for (int ai = 0; ai < 2; ++ai) tb[ai * 64 + fq * 16 + fr] = row_rstd16(rowsq, u.pm * BM + ai * HALF + wr * 64 + fq * 16 + fr);
#pragma unroll
        for (int ai = 0; ai < 2; ++ai)
#pragma unroll
            for (int m = 0; m < 4; ++m) {
                const int row = row0 + ai * HALF + m * 16; const float rs = tb[ai * 64 + m * 16 + fr];
                if (u.pn < 4) {
                    bf16_t* rowp = UV + (size_t)row * 1024 + u.pn * BM + wc * 32 + 8 * fq;
#pragma unroll
                    for (int bj = 0; bj < 2; ++bj) { const f32x4 v0 = acc[ai][bj][m][0] * rs, v1 = acc[ai][bj][m][1] * rs; u32x4 w;
                        w.x = cvt_pk_bf16(gelu_tanh(v0[0]), gelu_tanh(v0[1])); w.y = cvt_pk_bf16(gelu_tanh(v0[2]), gelu_tanh(v0[3]));
                        w.z = cvt_pk_bf16(gelu_tanh(v1[0]), gelu_tanh(v1[1])); w.w = cvt_pk_bf16(gelu_tanh(v1[2]), gelu_tanh(v1[3]));
                        *(u32x4*)(rowp + bj * HALF) = w; }
                } else {
                    bf16_t* rowp = Gb + (size_t)row * 512 + (u.pn - 4) * 128 + wc * 32 + 8 * fq;
                    const f32x4 a0 = acc[ai][0][m][0] * rs, a1 = acc[ai][0][m][1] * rs, g0 = acc[ai][1][m][0] * rs, g1 = acc[ai][1][m][1] * rs; u32x4 w;
                    w.x = cvt_pk_bf16(a0[0] * sigmoidf_(g0[0]), a0[1] * sigmoidf_(g0[1])); w.y = cvt_pk_bf16(a0[2] * sigmoidf_(g0[2]), a0[3] * sigmoidf_(g0[3]));
                    w.z = cvt_pk_bf16(a1[0] * sigmoidf_(g1[0]), a1[1] * sigmoidf_(g1[1])); w.w = cvt_pk_bf16(a1[2] * sigmoidf_(g1[2]), a1[3] * sigmoidf_(g1[3]));
                    *(u32x4*)rowp = w;
                }
            }
    }
};
struct EpiW1 {
    static constexpr bool PERM = true, AFTER_DRAIN = false;
    bf16_t* O; const float* rowsq; PG8_LAS float* tab;
    __device__ __forceinline__ void operator()(const f32x4 (&acc)[2][2][4][2], const Unit& u, int wr, int wc, int fr, int fq) const {
        const int row0 = u.pm * BM + wr * 64 + fr;
        PG8_LAS float* tb = tab + (wr * 4 + wc) * 128;
#pragma unroll
        for (int ai = 0; ai < 2; ++ai) tb[ai * 64 + fq * 16 + fr] = row_rstd16(rowsq, u.pm * BM + ai * HALF + wr * 64 + fq * 16 + fr);
#pragma unroll
        for (int ai = 0; ai < 2; ++ai)
#pragma unroll
            for (int m = 0; m < 4; ++m) {
                const int row = row0 + ai * HALF + m * 16; const float rs = tb[ai * 64 + m * 16 + fr];
                bf16_t* rowp = O + (size_t)row * 4096 + u.pn * BM + wc * 32 + 8 * fq;
#pragma unroll
                for (int bj = 0; bj < 2; ++bj) { f32x4 v0 = acc[ai][bj][m][0] * rs, v1 = acc[ai][bj][m][1] * rs; u32x4 w;
#pragma unroll
                    for (int e = 0; e < 4; ++e) { const float a = fmaxf(v0[e], 0.f), b = fmaxf(v1[e], 0.f); v0[e] = a * a; v1[e] = b * b; }
                    w.x = cvt_pk_bf16(v0[0], v0[1]); w.y = cvt_pk_bf16(v0[2], v0[3]); w.z = cvt_pk_bf16(v1[0], v1[1]); w.w = cvt_pk_bf16(v1[2], v1[3]);
                    *(u32x4*)(rowp + bj * HALF) = w; }
            }
    }
};
struct EpiRes {
    static constexpr bool PERM = true, AFTER_DRAIN = false;
    bf16_t* xb; float* rowsq; float* outf;
    __device__ __forceinline__ void operator()(const f32x4 (&acc)[2][2][4][2], const Unit& u, int wr, int wc, int fr, int fq) const {
        const int row0 = u.pm * BM + wr * 64 + fr, col0 = u.pn * BM + wc * 32 + 8 * fq;
#pragma unroll
        for (int ai = 0; ai < 2; ++ai) {
            u32x4 pre[4][2];
#pragma unroll
            for (int m = 0; m < 4; ++m)
#pragma unroll
                for (int bj = 0; bj < 2; ++bj) pre[m][bj] = *(const u32x4*)(xb + (size_t)(row0 + ai * HALF + m * 16) * 1024 + col0 + bj * HALF);
            asm volatile("" ::: "memory");
#pragma unroll
            for (int m = 0; m < 4; ++m) {
                const int row = row0 + ai * HALF + m * 16; const size_t off = (size_t)row * 1024 + col0; float ss = 0.f;
#pragma unroll
                for (int bj = 0; bj < 2; ++bj) {
                    const u32x4 w = pre[m][bj];
                    f32x4 v0 = acc[ai][bj][m][0], v1 = acc[ai][bj][m][1];
                    v0[0] += __uint_as_float(w.x << 16); v0[1] += __uint_as_float(w.x & 0xffff0000u); v0[2] += __uint_as_float(w.y << 16); v0[3] += __uint_as_float(w.y & 0xffff0000u);
                    v1[0] += __uint_as_float(w.z << 16); v1[1] += __uint_as_float(w.z & 0xffff0000u); v1[2] += __uint_as_float(w.w << 16); v1[3] += __uint_as_float(w.w & 0xffff0000u);
                    if (outf) { *(f32x4*)(outf + off + bj * HALF) = v0; *(f32x4*)(outf + off + bj * HALF + 4) = v1; }
                    else {
                        ss += ((v0[0] * v0[0] + v0[1] * v0[1]) + (v0[2] * v0[2] + v0[3] * v0[3])) + ((v1[0] * v1[0] + v1[1] * v1[1]) + (v1[2] * v1[2] + v1[3] * v1[3]));
                        u32x4 o; o.x = cvt_pk_bf16(v0[0], v0[1]); o.y = cvt_pk_bf16(v0[2], v0[3]); o.z = cvt_pk_bf16(v1[0], v1[1]); o.w = cvt_pk_bf16(v1[2], v1[3]);
                        *(u32x4*)(xb + off + bj * HALF) = o;
                    }
                }
                if (!outf) { ss += __shfl_xor(ss, 16); ss += __shfl_xor(ss, 32); if (fq == 0) rowsq[(size_t)row * 16 + u.pn * 4 + wc] = ss; }
            }
            asm volatile("" ::: "memory");
        }
    }
};
struct EpiQKV {
    static constexpr bool PERM = true, AFTER_DRAIN = false;
    bf16_t* Q; bf16_t* K; bf16_t* V; const float* rowsq; const float* qg; const float* kg; const float* ropeC; const float* ropeS; PG8_LAS float* tab;
    __device__ __forceinline__ void operator()(const f32x4 (&acc)[2][2][4][2], const Unit& u, int wr, int wc, int fr, int fq) const {
        const int row0 = u.pm * BM + wr * 64 + fr;
        PG8_LAS float* tb = tab + (wr * 4 + wc) * 128;
#pragma unroll
        for (int ai = 0; ai < 2; ++ai) tb[ai * 64 + fq * 16 + fr] = row_rstd16(rowsq, u.pm * BM + ai * HALF + wr * 64 + fq * 16 + fr);
        if (u.pn >= 8) {
#pragma unroll
            for (int ai = 0; ai < 2; ++ai)
#pragma unroll
                for (int m = 0; m < 4; ++m) {
                    const int row = row0 + ai * HALF + m * 16; const float rs = tb[ai * 64 + m * 16 + fr];
                    bf16_t* rowp = V + (size_t)row * 1024 + (u.pn - 8) * BM + wc * 32 + 8 * fq;
#pragma unroll
                    for (int bj = 0; bj < 2; ++bj) { const f32x4 v0 = acc[ai][bj][m][0] * rs, v1 = acc[ai][bj][m][1] * rs; u32x4 w;
                        w.x = cvt_pk_bf16(v0[0], v0[1]); w.y = cvt_pk_bf16(v0[2], v0[3]); w.z = cvt_pk_bf16(v1[0], v1[1]); w.w = cvt_pk_bf16(v1[2], v1[3]);
                        *(u32x4*)(rowp + bj * HALF) = w; }
                }
            return;
        }
        const bool isq = u.pn < 4; const int head = 4 * (u.pn & 3) + wc; const float* gp = isq ? qg : kg; bf16_t* dst = isq ? Q : K;
        const float osc = isq ? 0.125f * 1.4426950408889634f : 1.0f;
        f32x4 gv[2][2];
#pragma unroll
        for (int bj = 0; bj < 2; ++bj)
#pragma unroll
            for (int n = 0; n < 2; ++n) gv[bj][n] = *(const f32x4*)(gp + bj * 32 + 8 * fq + 4 * n) * osc;
#pragma unroll
        for (int aim = 0; aim < 4; ++aim) {
            const int ai = aim >> 1;
            f32x4 rc[4][2], rsn[4][2];
#pragma unroll
            for (int m = 2 * (aim & 1); m < 2 * (aim & 1) + 2; ++m)
#pragma unroll
                for (int n = 0; n < 2; ++n) { const int pos = (row0 + ai * HALF + m * 16) & 8191; rc[m][n] = *(const f32x4*)(ropeC + pos * 8 + 4 * n); rsn[m][n] = *(const f32x4*)(ropeS + pos * 8 + 4 * n); }
            asm volatile("" ::: "memory");
#pragma unroll
            for (int m = 2 * (aim & 1); m < 2 * (aim & 1) + 2; ++m) {
                const int row = row0 + ai * HALF + m * 16; const float rs = tb[ai * 64 + m * 16 + fr];
                f32x4 v[2][2]; float ss = 0.f;
#pragma unroll
                for (int bj = 0; bj < 2; ++bj)
#pragma unroll
                    for (int n = 0; n < 2; ++n) { v[bj][n] = acc[ai][bj][m][n] * rs; const f32x4 t = v[bj][n]; ss += (t[0] * t[0] + t[1] * t[1]) + (t[2] * t[2] + t[3] * t[3]); }
                ss += __shfl_xor(ss, 16); ss += __shfl_xor(ss, 32);
                const float hr = __builtin_amdgcn_rsqf(ss * (1.0f / 64.0f) + 1e-6f);
#pragma unroll
                for (int bj = 0; bj < 2; ++bj)
#pragma unroll
                    for (int n = 0; n < 2; ++n) v[bj][n] = v[bj][n] * hr * gv[bj][n];
#pragma unroll
                for (int n = 0; n < 2; ++n) {
                    const f32x4 c = rc[m][n], s = rsn[m][n];
                    f32x4 mine = v[0][n], other;
#pragma unroll
                    for (int e = 0; e < 4; ++e) other[e] = __shfl_xor(mine[e], 16);
                    if (fq == 0) v[0][n] = mine * c - other * s;
                    else if (fq == 1) v[0][n] = mine * c + other * s;
                }
                bf16_t* rowp = dst + (size_t)row * 1024 + head * 64 + 8 * fq;
#pragma unroll
                for (int bj = 0; bj < 2; ++bj) { u32x4 w; w.x = cvt_pk_bf16(v[bj][0][0], v[bj][0][1]); w.y = cvt_pk_bf16(v[bj][0][2], v[bj][0][3]);
                    w.z = cvt_pk_bf16(v[bj][1][0], v[bj][1][1]); w.w = cvt_pk_bf16(v[bj][1][2], v[bj][1][3]); *(u32x4*)(rowp + bj * 32) = w; }
            }
            asm volatile("" ::: "memory");
        }
    }
};
template <class Epi, class Sched, bool ALIGN_EPI = false, bool SP2 = false>
__device__ __forceinline__ void gemm_phase(PG8_LAS unsigned char* lds, const Gemm g, const Sched& S, const Epi& E) {
    int tid = threadIdx.x; asm volatile("" : "+v"(tid));
    const int wid = __builtin_amdgcn_readfirstlane(tid >> 6), lane = tid & 63, wr = wid >> 2, wc = wid & 3, fr = lane & 15, fq = lane >> 4;
    const int K = g.K, nt = K / BK;
    unsigned voffA[2], voffB[2];
#pragma unroll
    for (int i = 0; i < 2; ++i) { int R, C; stage_rc(tid * 16 + i * 8192, R, C); const int Rb = Epi::PERM ? ((R & ~31) + perm32(R & 31)) : R;
        voffA[i] = (unsigned)(R * K + C) * 2u; voffB[i] = (unsigned)(Rb * K + C) * 2u; }
    const size_t kstep = (size_t)(BK * 2);
    const size_t hstep = (size_t)HALF * K * 2;
    const size_t tstep = 2 * hstep;
    const unsigned ldsw = (unsigned)wid * 1024u;
    const int aoff = lds_byte(wr * 64 + fr, fq * 8), boff = lds_byte(wc * 32 + fr, fq * 8);
#define PG8_SA(b, h) (((b) * 2 + (h)) * HTB)
#define PG8_SB(b, h) ((4 + (b) * 2 + (h)) * HTB)
#define PG8_STAGE(bufoff, gbase, voff) do { _Pragma("unroll") for (int _i = 0; _i < 2; ++_i) \
        __builtin_amdgcn_global_load_lds((const unsigned*)((const char*)(gbase) + (voff)[_i]), (PG8_LAS unsigned*)(lds + (bufoff) + ldsw + _i * 8192), 16, 0, 0); } while (0)
#define PG8_LDA(dst, b, h) do { _Pragma("unroll") for (int m = 0; m < 4; ++m) _Pragma("unroll") for (int k = 0; k < 2; ++k) dst[m][k] = *(const PG8_LAS bf16x8*)(lds + PG8_SA(b, h) + aoff + m * 2048 + k * 1024); } while (0)
#define PG8_LDB(dst, b, h) do { _Pragma("unroll") for (int n = 0; n < 2; ++n) _Pragma("unroll") for (int k = 0; k < 2; ++k) dst[n][k] = *(const PG8_LAS bf16x8*)(lds + PG8_SB(b, h) + boff + n * 2048 + k * 1024); } while (0)
#define PG8_MMA(ai, bj, At, Bt) do { __builtin_amdgcn_s_setprio(1); _Pragma("unroll") for (int m = 0; m < 4; ++m) _Pragma("unroll") for (int n = 0; n < 2; ++n) _Pragma("unroll") for (int k = 0; k < 2; ++k) \
        acc[ai][bj][m][n] = __builtin_amdgcn_mfma_f32_16x16x32_bf16(Bt[n][k], At[m][k], acc[ai][bj][m][n], 0, 0, 0); __builtin_amdgcn_s_setprio(0); } while (0)
#define PG8_WAIT_V(n) asm volatile("s_waitcnt vmcnt(" #n ")" ::: "memory")
#define PG8_WAIT_L(n) asm volatile("s_waitcnt lgkmcnt(" #n ")" ::: "memory")
#define PG8_BAR __builtin_amdgcn_s_barrier()
#define PG8_SCHED __builtin_amdgcn_sched_barrier(0)
    Unit cur, nxt; int ui = 0;
    if (!S.next(0, cur)) return;
    f32x4 acc[2][2][4][2];
#pragma unroll
    for (int a = 0; a < 2; ++a)
#pragma unroll
        for (int b = 0; b < 2; ++b)
#pragma unroll
            for (int m = 0; m < 4; ++m)
#pragma unroll
                for (int n = 0; n < 2; ++n) acc[a][b][m][n] = (f32x4){0.f, 0.f, 0.f, 0.f};
    bf16x8 At[4][2], B0[2][2], B1[2][2];
    const char* cA = (const char*)g.A + (size_t)cur.pm * tstep; const char* cB = (const char*)g.Bt + (size_t)cur.pn * tstep;
    S.a_ready(cur);
    if constexpr (SP2) {
        PG8_STAGE(PG8_SB(0, 0), cB, voffB); PG8_STAGE(PG8_SB(0, 1), cB + hstep, voffB); PG8_STAGE(PG8_SA(0, 0), cA, voffA); PG8_STAGE(PG8_SA(0, 1), cA + hstep, voffA);
        if (wr == 1) PG8_BAR;
        PG8_WAIT_V(2); PG8_BAR;
        PG8_STAGE(PG8_SB(1, 0), cB + kstep, voffB); PG8_STAGE(PG8_SA(1, 0), cA + kstep, voffA); PG8_STAGE(PG8_SB(1, 1), cB + hstep + kstep, voffB);
        PG8_WAIT_V(6); PG8_BAR;
    } else {
        PG8_STAGE(PG8_SB(0, 0), cB, voffB); PG8_STAGE(PG8_SA(0, 0), cA, voffA); PG8_STAGE(PG8_SB(0, 1), cB + hstep, voffB); PG8_STAGE(PG8_SA(0, 1), cA + hstep, voffA);
        if (wr == 1) PG8_BAR;
        PG8_WAIT_V(4); PG8_BAR;
        PG8_STAGE(PG8_SB(1, 0), cB + kstep, voffB); PG8_STAGE(PG8_SA(1, 0), cA + kstep, voffA); PG8_STAGE(PG8_SB(1, 1), cB + hstep + kstep, voffB);
        PG8_WAIT_V(6); PG8_BAR;
    }
    for (;;) {
        const bool has_next = S.next(ui + 1, nxt);
        const char* nA = has_next ? (const char*)g.A + (size_t)nxt.pm * tstep : cA; const char* nB = has_next ? (const char*)g.Bt + (size_t)nxt.pn * tstep : cB;
        for (int t = 0; t < nt; t += 2) {
            const bool last = (t == nt - 2);
            const char* a1 = cA + (size_t)(t + 1) * kstep;
            const char* a2 = last ? nA : cA + (size_t)(t + 2) * kstep; const char* b2 = last ? nB : cB + (size_t)(t + 2) * kstep;
            const char* a3 = a2 + kstep; const char* b3 = b2 + kstep;
            if (last && has_next) S.a_ready(nxt);
            if constexpr (SP2) {
            PG8_LDB(B0, 0, 0); PG8_LDB(B1, 0, 1); PG8_SCHED; PG8_LDA(At, 0, 0); PG8_STAGE(PG8_SA(1, 1), a1 + hstep, voffA);
            PG8_WAIT_V(8); PG8_WAIT_L(0); PG8_BAR; PG8_MMA(0, 0, At, B0); PG8_MMA(0, 1, At, B1); PG8_BAR; PG8_SCHED;
            PG8_LDA(At, 0, 1); PG8_STAGE(PG8_SB(0, 0), b2, voffB); PG8_STAGE(PG8_SB(0, 1), b2 + hstep, voffB); PG8_STAGE(PG8_SA(0, 0), a2, voffA);
            PG8_WAIT_V(8); PG8_WAIT_L(0); PG8_BAR; PG8_MMA(1, 0, At, B0); PG8_MMA(1, 1, At, B1); PG8_BAR; PG8_SCHED;
            PG8_LDB(B0, 1, 0); PG8_LDB(B1, 1, 1); PG8_SCHED; PG8_LDA(At, 1, 0); PG8_STAGE(PG8_SA(0, 1), a2 + hstep, voffA);
            PG8_WAIT_V(8); PG8_WAIT_L(0); PG8_BAR; PG8_MMA(0, 0, At, B0); PG8_MMA(0, 1, At, B1); PG8_BAR; PG8_SCHED;
            PG8_LDA(At, 1, 1); PG8_STAGE(PG8_SB(1, 0), b3, voffB); PG8_STAGE(PG8_SB(1, 1), b3 + hstep, voffB); PG8_STAGE(PG8_SA(1, 0), a3, voffA);
            PG8_WAIT_V(8); PG8_WAIT_L(0); PG8_BAR; PG8_MMA(1, 0, At, B0); PG8_MMA(1, 1, At, B1); PG8_BAR; PG8_SCHED;
            } else {
            PG8_LDB(B0, 0, 0); PG8_SCHED; PG8_LDA(At, 0, 0); PG8_STAGE(PG8_SA(1, 1), a1 + hstep, voffA);
            PG8_WAIT_L(8); PG8_BAR; PG8_WAIT_L(0); PG8_MMA(0, 0, At, B0); PG8_BAR; PG8_SCHED;
            PG8_LDB(B1, 0, 1); PG8_STAGE(PG8_SB(0, 0), b2, voffB);
            PG8_BAR; PG8_WAIT_L(0); PG8_MMA(0, 1, At, B1); PG8_BAR;
            PG8_LDA(At, 0, 1); PG8_STAGE(PG8_SA(0, 0), a2, voffA);
            PG8_BAR; PG8_WAIT_L(0); PG8_MMA(1, 0, At, B0); PG8_BAR; PG8_SCHED;
            PG8_STAGE(PG8_SB(0, 1), b2 + hstep, voffB);
            PG8_WAIT_V(6); PG8_BAR; PG8_MMA(1, 1, At, B1); PG8_BAR;
            PG8_LDB(B0, 1, 0); PG8_SCHED; PG8_LDA(At, 1, 0); PG8_STAGE(PG8_SA(0, 1), a2 + hstep, voffA);
            PG8_WAIT_L(8); PG8_BAR; PG8_WAIT_L(0); PG8_MMA(0, 0, At, B0); PG8_BAR; PG8_SCHED;
            PG8_LDB(B1, 1, 1); PG8_STAGE(PG8_SB(1, 0), b3, voffB);
            PG8_BAR; PG8_WAIT_L(0); PG8_MMA(0, 1, At, B1); PG8_BAR;
            PG8_LDA(At, 1, 1); PG8_STAGE(PG8_SA(1, 0), a3, voffA);
            PG8_BAR; PG8_WAIT_L(0); PG8_MMA(1, 0, At, B0); PG8_BAR; PG8_SCHED;
            PG8_STAGE(PG8_SB(1, 1), b3 + hstep, voffB);
            PG8_WAIT_V(6); PG8_BAR; PG8_MMA(1, 1, At, B1); PG8_BAR;
            }
        }
        if constexpr (ALIGN_EPI) { if (wr == 0) PG8_BAR; }
        if constexpr (!Epi::AFTER_DRAIN) { E(acc, cur, wr, wc, fr, fq); S.done(cur); }
        if (!has_next) break;
#pragma unroll
        for (int a = 0; a < 2; ++a)
#pragma unroll
            for (int b = 0; b < 2; ++b)
#pragma unroll
                for (int m = 0; m < 4; ++m)
#pragma unroll
                    for (int n = 0; n < 2; ++n) acc[a][b][m][n] = (f32x4){0.f, 0.f, 0.f, 0.f};
        cur = nxt; cA = nA; cB = nB; ++ui;
        if constexpr (ALIGN_EPI) { if (wr == 1) PG8_BAR; }
    }
    PG8_WAIT_V(0);
    if constexpr (!ALIGN_EPI) { if (wr == 0) PG8_BAR; }
    PG8_BAR;
    if constexpr (Epi::AFTER_DRAIN) { E.fused(acc, cur, wr, wc, fr, fq, lds, wid, lane); S.done(cur); }
#undef PG8_SA
#undef PG8_SB
#undef PG8_STAGE
#undef PG8_LDA
#undef PG8_LDB
#undef PG8_MMA
#undef PG8_WAIT_V
#undef PG8_WAIT_L
#undef PG8_BAR
#undef PG8_SCHED
}
}
#ifndef EN
#define EN 255
#endif
#define LAS __attribute__((address_space(3)))
typedef unsigned short bf16_t;
typedef short bf16x8 __attribute__((ext_vector_type(8)));
typedef short s16x4 __attribute__((ext_vector_type(4)));
typedef float f32x4 __attribute__((ext_vector_type(4)));
typedef float f32x2 __attribute__((ext_vector_type(2)));
typedef unsigned u32x4 __attribute__((ext_vector_type(4)));
typedef unsigned u32x2 __attribute__((ext_vector_type(2)));
using pg8::cvt_pk_bf16; using pg8::sigmoidf_;

constexpr int M = 16384, D = 1024, SEQ = 8192, FF = 4096, NTHR = 512;
constexpr size_t MiB = 1u << 20;
constexpr size_t WS_ROWSQ = 1 * MiB, WS_ROPEC = 2 * MiB, WS_ROPES = 2 * MiB + 256 * 1024, WS_SPW = 2 * MiB + 512 * 1024;
constexpr size_t WS_W1 = 4 * MiB  , WS_W2 = 36 * MiB  , WS_ABIN = 68 * MiB  , WS_ABOUT = 76 * MiB  , WS_QKV = 80 * MiB  , WS_COUT = 92 * MiB  ;
constexpr size_t WS_XB = 96 * MiB, WS_BIG = 128 * MiB, WS_END = 256 * MiB;
constexpr size_t WS_UV = WS_BIG, WS_GB = WS_BIG + 32 * MiB, WS_CAT = WS_BIG + 48 * MiB;
constexpr size_t WS_Q = WS_BIG, WS_K = WS_BIG + 32 * MiB, WS_V = WS_BIG + 64 * MiB, WS_O = WS_BIG + 96 * MiB;
#ifndef WG_G1
#define WG_G1 1
#endif
#ifndef WG_G2
#define WG_G2 2
#endif
#ifndef WG_G3
#define WG_G3 2
#endif
#ifndef WG_G4
#define WG_G4 2
#endif
constexpr int LDS_BYTES = 139264;

struct Args { const float* in[19]; float* out; unsigned char* ws; int coop, ph_lo, ph_hi, pad; };

__device__ __forceinline__ float wave_sum(float v) {
#pragma unroll
    for (int o = 1; o < 64; o <<= 1) v += __shfl_xor(v, o);
    return v;
}
__device__ __forceinline__ float bf_lo(unsigned w) { return __uint_as_float(w << 16); }
__device__ __forceinline__ float bf_hi(unsigned w) { return __uint_as_float(w & 0xffff0000u); }

template <int MODE> __device__ __forceinline__ int rowmap(int n) {
    if (MODE == 1) {
        if (n < 1024) return n; const int j = (n - 1024) & 511, gate = (n - 1024) >> 9; return 1024 + 256 * (j >> 7) + 128 * gate + (j & 127);
    } else if (MODE == 2) {
        if (n >= 2048) return n; const int base = n & ~1023, r = n & 1023, head = r >> 6, d = r & 63; return base + 256 * (head >> 2) + 128 * (d >> 5) + 32 * (head & 3) + (d & 31);
    }
    return n;
}
template <int MODE> __device__ __forceinline__ void p0_transpose_item(const float* W, int K, int N, bf16_t* WT, const float* gk, LAS float* scr, int item, int lane) {
    const int nblk = N / 64, kb = item / nblk, nb = item % nblk, k0 = 64 * kb, n0 = 64 * nb, l15 = lane & 15, l4 = lane >> 4;
    f32x4 v[16];
#pragma unroll
    for (int i = 0; i < 16; ++i) v[i] = __builtin_nontemporal_load((const f32x4*)(W + (size_t)(k0 + 4 * i + l4) * N + n0 + 4 * l15));
    if (gk) {
#pragma unroll
        for (int i = 0; i < 16; ++i) v[i] = v[i] * gk[k0 + 4 * i + l4];
    }
#pragma unroll
    for (int i = 0; i < 16; ++i) { const int kk = 4 * i + l4; *(LAS f32x4*)(scr + kk * 64 + ((4 * l15) ^ (8 * (kk >> 3)))) = v[i]; }
    asm volatile("s_waitcnt lgkmcnt(0)" ::: "memory");
    const int c = lane & 7, nq = lane >> 3;
#pragma unroll
    for (int j = 0; j < 8; ++j) { const int n = nq + 8 * j; const LAS float* sp = scr + (8 * c) * 64 + (n ^ (8 * c));
        u32x4 o; o.x = cvt_pk_bf16(sp[0 * 64], sp[1 * 64]); o.y = cvt_pk_bf16(sp[2 * 64], sp[3 * 64]); o.z = cvt_pk_bf16(sp[4 * 64], sp[5 * 64]); o.w = cvt_pk_bf16(sp[6 * 64], sp[7 * 64]);
        *(u32x4*)(WT + (size_t)rowmap<MODE>(n0 + n) * K + k0 + 8 * c) = o; }
    asm volatile("s_waitcnt lgkmcnt(0)" ::: "memory");
}
template <int MODE> __device__ __forceinline__ void p0_matrix(const float* W, int K, int N, bf16_t* WT, const float* gk, LAS float* scr, int gw, int NGW, int lane) {
    const int nitems = (K / 64) * (N / 64);
    for (int it = gw; it < nitems; it += NGW) p0_transpose_item<MODE>(W, K, N, WT, gk, scr, it, lane);
}
__device__ __forceinline__ void sincos_d(double a, float& c, float& s) {
    const double twopi = 6.283185307179586476925286766559, inv = 0.15915494309189533576888376337251;
    const double k = __builtin_rint(a * inv); const double r = (a - k * twopi) * 0.25, r2 = r * r;
    double sn = 1.0, cs = 1.0;
    sn = r * (1.0 + r2 * (-1.0 / 6 + r2 * (1.0 / 120 + r2 * (-1.0 / 5040 + r2 * (1.0 / 362880 + r2 * (-1.0 / 39916800 + r2 * (1.0 / 6227020800.0 + r2 * (-1.0 / 1307674368000.0))))))));
    cs = 1.0 + r2 * (-0.5 + r2 * (1.0 / 24 + r2 * (-1.0 / 720 + r2 * (1.0 / 40320 + r2 * (-1.0 / 3628800 + r2 * (1.0 / 479001600.0 + r2 * (-1.0 / 87178291200.0 + r2 * (1.0 / 20922789888000.0))))))));
    double s2 = 2.0 * sn * cs, c2 = cs * cs - sn * sn; const double s4 = 2.0 * s2 * c2, c4 = c2 * c2 - s2 * s2;
    c = (float)c4; s = (float)s4;
}
__device__ __forceinline__ void p0_prologue(const Args& A, LAS unsigned char* lds, int tid, int lane, int wave) {
    unsigned char* ws = A.ws;
    LAS float* scr = (LAS float*)(lds + wave * 16384);
    const int gw = blockIdx.x * 8 + wave, NGW = gridDim.x * 8;
    const float* mixg = A.in[1]; const float* mlpg = A.in[2];
    for (int it = gw; it < 8192 + 2 * 1792; it += NGW) {
        int r = it;
        if (r < 4096) { const int l = r >> 10; p0_transpose_item<0>(A.in[3] + (size_t)l * D * FF, D, FF, (bf16_t*)(ws + WS_W1 + l * 8 * MiB), mlpg + l * D, scr, r & 1023, lane); continue; }
        r -= 4096;
        if (r < 4096) { const int l = r >> 10; p0_transpose_item<0>(A.in[4] + (size_t)l * D * FF, FF, D, (bf16_t*)(ws + WS_W2 + l * 8 * MiB), nullptr, scr, r & 1023, lane); continue; }
        r -= 4096;
        const int i = r >= 1792 ? 1 : 0; r -= i * 1792;
        if (r < 512) { p0_transpose_item<1>(A.in[5] + (size_t)i * D * 2048, D, 2048, (bf16_t*)(ws + WS_ABIN + i * 4 * MiB), mixg + (2 * i) * D, scr, r, lane); continue; }
        r -= 512;
        if (r < 256) { p0_transpose_item<0>(A.in[14] + (size_t)i * D * D, D, D, (bf16_t*)(ws + WS_ABOUT + i * 2 * MiB), nullptr, scr, r, lane); continue; }
        r -= 256;
        if (r < 768) { p0_transpose_item<2>(A.in[15] + (size_t)i * D * 3072, D, 3072, (bf16_t*)(ws + WS_QKV + i * 6 * MiB), mixg + (2 * i + 1) * D, scr, r, lane); continue; }
        r -= 768;
        p0_transpose_item<0>(A.in[18] + (size_t)i * D * D, D, D, (bf16_t*)(ws + WS_COUT + i * 2 * MiB), nullptr, scr, r, lane);
    }
    { const float* sw = A.in[6]; bf16_t* o = (bf16_t*)(ws + WS_SPW); const int gt = blockIdx.x * NTHR + tid, NT = gridDim.x * NTHR;
      for (int e = gt; e < 2 * 8 * 128 * 128 / 2; e += NT) { const f32x2 v = *(const f32x2*)(sw + 2 * (size_t)e); ((unsigned*)o)[e] = cvt_pk_bf16(v[0], v[1]); } }
    { float* rc = (float*)(ws + WS_ROPEC); float* rsn = (float*)(ws + WS_ROPES); const int gt = blockIdx.x * NTHR + tid, NT = gridDim.x * NTHR;
      for (int e = gt; e < SEQ * 8; e += NT) { const int pos = e >> 3, i = e & 7;
          const float f = i == 0 ? 1.0f : i == 1 ? 0.1939227432012558f : i == 2 ? 0.03760603070259094f : i == 3 ? 0.007292664609849453f : i == 4 ? 0.0014142135623842478f : i == 5 ? 0.00027424818836152554f : i == 6 ? 5.3182957344688475e-05f : 1.0313385246263351e-05f;
          const float ang = (float)pos * f; float c, s; sincos_d((double)ang, c, s); rc[e] = c; rsn[e] = s; } }
    { const float* x = A.in[0]; bf16_t* xb = (bf16_t*)(ws + WS_XB); float* rowsq = (float*)(ws + WS_ROWSQ);
      for (int m = gw; m < M; m += NGW) {
          const f32x4* xr = (const f32x4*)(x + (size_t)m * D) + lane; f32x4 v[4]; float s = 0.f;
#pragma unroll
          for (int j = 0; j < 4; ++j) { v[j] = __builtin_nontemporal_load(xr + 64 * j); s += (v[j][0] * v[j][0] + v[j][1] * v[j][1]) + (v[j][2] * v[j][2] + v[j][3] * v[j][3]); }
          s = wave_sum(s);
          u32x2* o = (u32x2*)(xb + (size_t)m * D) + lane;
#pragma unroll
          for (int j = 0; j < 4; ++j) { u32x2 w; w.x = cvt_pk_bf16(v[j][0], v[j][1]); w.y = cvt_pk_bf16(v[j][2], v[j][3]); o[64 * j] = w; }
          if (lane < 16) rowsq[(size_t)m * 16 + lane] = lane == 0 ? s : 0.f;
      } }
}

template <int CTRL> __device__ __forceinline__ float dppx(float v) { return __builtin_bit_cast(float, __builtin_amdgcn_update_dpp(0, __builtin_bit_cast(int, v), CTRL, 0xf, 0xf, true)); }
__device__ __forceinline__ float sum16(float v) {
    v += dppx<0xB1>(v); v += dppx<0x4E>(v); v += dppx<0x141>(v); v += dppx<0x140>(v); return v;
}
constexpr int VN_STRIDE = 672;
__device__ __forceinline__ bf16x8 tr_pair(const LAS unsigned char* p_lo, const LAS unsigned char* p_hi) {
    const s16x4 lo = __builtin_bit_cast(s16x4, __builtin_amdgcn_ds_read_tr16_b64_v4i16((LAS s16x4*)p_lo));
    const s16x4 hi = __builtin_bit_cast(s16x4, __builtin_amdgcn_ds_read_tr16_b64_v4i16((LAS s16x4*)p_hi));
    return (bf16x8){lo[0], lo[1], lo[2], lo[3], hi[0], hi[1], hi[2], hi[3]};
}
__device__ __forceinline__ void mixa_item(const Args& A, int li, int item, LAS unsigned char* lds, int tid, int lane, int wave) {
    const int chunk = item >> 1, gh = item & 1, row0 = chunk * 128;
    const bf16_t* UV = (const bf16_t*)(A.ws + WS_UV); bf16_t* CAT = (bf16_t*)(A.ws + WS_CAT);
    const float* vg = A.in[8] + li * 512; const float* vb = A.in[9] + li * 512; const float* spb = A.in[7] + li * 8 * 128;
    const bf16_t* spw = (const bf16_t*)(A.ws + WS_SPW) + (size_t)li * 8 * 128 * 128;
    {
        const int l15 = lane & 15, l4 = lane >> 4;
        f32x4 gA[2][2], bA[2][2];
#pragma unroll
        for (int i = 0; i < 2; ++i) { const int chn = (l15 + 16 * (2 * gh + i)) * 8;
            gA[i][0] = *(const f32x4*)(vg + chn); gA[i][1] = *(const f32x4*)(vg + chn + 4); bA[i][0] = *(const f32x4*)(vb + chn); bA[i][1] = *(const f32x4*)(vb + chn + 4); }
        u32x4 w[4][4];
#pragma unroll
        for (int it = 0; it < 4; ++it)
#pragma unroll
            for (int i = 0; i < 4; ++i) w[it][i] = *(const u32x4*)(UV + (size_t)(row0 + wave * 16 + it * 4 + l4) * 1024 + 512 + (l15 + 16 * i) * 8);
        u32x4 wsel[4][2];
#pragma unroll
        for (int it = 0; it < 4; ++it)
#pragma unroll
            for (int i = 0; i < 2; ++i) wsel[it][i] = *(const u32x4*)(UV + (size_t)(row0 + wave * 16 + it * 4 + l4) * 1024 + 512 + (l15 + 16 * (2 * gh + i)) * 8);
#pragma unroll
        for (int it = 0; it < 4; ++it) {
            const int q = wave * 16 + it * 4 + l4; float s1 = 0.f, s2 = 0.f;
#pragma unroll
            for (int i = 0; i < 4; ++i)
#pragma unroll
                for (int e = 0; e < 4; ++e) { const float a = bf_lo(w[it][i][e]), b = bf_hi(w[it][i][e]); s1 += a + b; s2 += a * a + b * b; }
            s1 = sum16(s1); s2 = sum16(s2);
            const float mean = s1 * (1.0f / 512.0f), rstd = __builtin_amdgcn_rsqf(fmaxf(s2 * (1.0f / 512.0f) - mean * mean, 0.f) + 1e-6f);
#pragma unroll
            for (int i = 0; i < 2; ++i) {
                const u32x4 ww = wsel[it][i]; u32x4 o;
#pragma unroll
                for (int e = 0; e < 4; ++e) { const int h2 = e >> 1, k2 = (e & 1) * 2;
                    const float a = (bf_lo(ww[e]) - mean) * rstd * gA[i][h2][k2] + bA[i][h2][k2], b = (bf_hi(ww[e]) - mean) * rstd * gA[i][h2][k2 + 1] + bA[i][h2][k2 + 1];
                    o[e] = cvt_pk_bf16(a, b); }
                *(LAS u32x4*)(lds + q * VN_STRIDE + (l15 + 16 * i) * 16) = o;
            }
        }
    }
    __syncthreads();
    const int gl = wave >> 1, ph = wave & 1, gg = gh * 4 + gl, g = lane >> 4, i16 = lane & 15;
    f32x4 acc[4][4];
#pragma unroll
    for (int a = 0; a < 4; ++a)
#pragma unroll
        for (int b = 0; b < 4; ++b) acc[a][b] = (f32x4){0.f, 0.f, 0.f, 0.f};
    const LAS unsigned char* trb = lds + (4 * g + (i16 >> 2)) * VN_STRIDE + (gl * 64 + 4 * (i16 & 3)) * 2;
    const bf16_t* wb = spw + ((size_t)gg * 128 + ph * 64 + i16) * 128 + 4 * g;
#pragma unroll
    for (int ks = 0; ks < 4; ++ks) {
        bf16x8 af[4], bfr[4];
#pragma unroll
        for (int cb = 0; cb < 4; ++cb) af[cb] = tr_pair(trb + (32 * ks) * VN_STRIDE + cb * 32, trb + (32 * ks + 16) * VN_STRIDE + cb * 32);
#pragma unroll
        for (int pb = 0; pb < 4; ++pb) { const s16x4 lo = *(const s16x4*)(wb + pb * 16 * 128 + 32 * ks), hi = *(const s16x4*)(wb + pb * 16 * 128 + 32 * ks + 16);
            bfr[pb] = (bf16x8){lo[0], lo[1], lo[2], lo[3], hi[0], hi[1], hi[2], hi[3]}; }
#pragma unroll
        for (int cb = 0; cb < 4; ++cb)
#pragma unroll
            for (int pb = 0; pb < 4; ++pb) acc[cb][pb] = __builtin_amdgcn_mfma_f32_16x16x32_bf16(af[cb], bfr[pb], acc[cb][pb], 0, 0, 0);
    }
    u32x2 uw[4][4]; float sbv[4];
#pragma unroll
    for (int pb = 0; pb < 4; ++pb) { const int p = ph * 64 + pb * 16 + i16; sbv[pb] = spb[gg * 128 + p];
#pragma unroll
        for (int cb = 0; cb < 4; ++cb) uw[pb][cb] = *(const u32x2*)(UV + (size_t)(row0 + p) * 1024 + gg * 64 + cb * 16 + 4 * g); }
    asm volatile("" ::: "memory");
#pragma unroll
    for (int pb = 0; pb < 4; ++pb) {
        const int p = ph * 64 + pb * 16 + i16;
#pragma unroll
        for (int cb = 0; cb < 4; ++cb) {
            const size_t off = (size_t)(row0 + p) * 1024 + gg * 64 + cb * 16 + 4 * g;
            const f32x4 sv = acc[cb][pb] + sbv[pb];
            u32x2 o; o.x = cvt_pk_bf16(bf_lo(uw[pb][cb].x) * sv[0], bf_hi(uw[pb][cb].x) * sv[1]); o.y = cvt_pk_bf16(bf_lo(uw[pb][cb].y) * sv[2], bf_hi(uw[pb][cb].y) * sv[3]);
            *(u32x2*)(CAT + off) = o;
        }
    }
    __syncthreads();
}
constexpr int CV_STRIDE = 516;
constexpr int GT_BYTES = 62 * 1024;
__device__ __forceinline__ void mixb_item(const Args& A, int li, int item, LAS unsigned char* lds, int tid, int lane, int wave) {
    const int row0 = item * 32, bb = row0 >> 13, pos0 = row0 & 8191;
    const bf16_t* Gb = (const bf16_t*)(A.ws + WS_GB); bf16_t* CAT = (bf16_t*)(A.ws + WS_CAT);
    const float* cw = A.in[10] + (size_t)li * 31 * 512; const float* cb = A.in[11] + li * 512; const float* ng = A.in[12] + li * 512; const float* nb = A.in[13] + li * 512;
    LAS float* cv = (LAS float*)(lds + 65536);
    {
        u32x4 st[8];
#pragma unroll
        for (int i = 0; i < 8; ++i) { const int idx = tid + NTHR * i, row = idx >> 6, ch = idx & 63, pos = pos0 - 15 + row; const bool ok = idx < 62 * 64 && pos >= 0 && pos < SEQ;
            st[i] = ok ? *(const u32x4*)(Gb + ((size_t)bb * SEQ + (ok ? pos : pos0)) * 512 + ch * 8) : (u32x4){0u, 0u, 0u, 0u}; }
#pragma unroll
        for (int i = 0; i < 8; ++i) { const int idx = tid + NTHR * i; if (idx < 62 * 64) *(LAS u32x4*)(lds + idx * 16) = st[i]; }
    }
    const int cp = tid & 255, tg = wave >> 2;
    const f32x2 bias = *(const f32x2*)(cb + 2 * cp);
    __syncthreads();
#pragma unroll 1
    for (int sb = 0; sb < 2; ++sb) {
        const int t0 = tg * 16 + sb * 8;
        float a0[8], a1[8];
#pragma unroll
        for (int t = 0; t < 8; ++t) { a0[t] = bias[0]; a1[t] = bias[1]; }
#pragma unroll 1
        for (int jc = 0; jc < 4; ++jc) {
            const LAS unsigned* ip = (const LAS unsigned*)(lds + (t0 + jc * 8) * 1024) + cp;
            unsigned in[15]; f32x2 w[8];
#pragma unroll
            for (int jj = 0; jj < 8; ++jj) { const int j = jc * 8 + jj; const f32x2 wv = *(const f32x2*)(cw + (j < 31 ? j : 30) * 512 + 2 * cp); w[jj] = j < 31 ? wv : (f32x2){0.f, 0.f}; }
#pragma unroll
            for (int k = 0; k < 15; ++k) in[k] = ip[k * 256];
#pragma unroll
            for (int t = 0; t < 8; ++t)
#pragma unroll
                for (int jj = 0; jj < 8; ++jj) { a0[t] += bf_lo(in[t + jj]) * w[jj][0]; a1[t] += bf_hi(in[t + jj]) * w[jj][1]; }
        }
#pragma unroll
        for (int t = 0; t < 8; ++t) *(LAS f32x2*)(cv + (t0 + t) * CV_STRIDE + 2 * cp) = (f32x2){a0[t], a1[t]};
    }
    __syncthreads();
    {
        const int l15 = lane & 15, t = wave * 4 + (lane >> 4);
        f32x4 v[8]; float s1 = 0.f, s2 = 0.f;
#pragma unroll
        for (int i = 0; i < 8; ++i) { v[i] = *(const LAS f32x4*)(cv + t * CV_STRIDE + (l15 + 16 * i) * 4); s1 += (v[i][0] + v[i][1]) + (v[i][2] + v[i][3]); s2 += (v[i][0] * v[i][0] + v[i][1] * v[i][1]) + (v[i][2] * v[i][2] + v[i][3] * v[i][3]); }
        s1 = sum16(s1); s2 = sum16(s2);
        const float mean = s1 * (1.0f / 512.0f), rstd = __builtin_amdgcn_rsqf(fmaxf(s2 * (1.0f / 512.0f) - mean * mean, 0.f) + 1e-6f);
        f32x4 gq[8], bq[8];
#pragma unroll
        for (int i = 0; i < 8; ++i) { const int c0 = (l15 + 16 * i) * 4; gq[i] = *(const f32x4*)(ng + c0); bq[i] = *(const f32x4*)(nb + c0); }
        asm volatile("" ::: "memory");
#pragma unroll
        for (int i = 0; i < 8; ++i) { const int c0 = (l15 + 16 * i) * 4; const f32x4 g4 = gq[i], b4 = bq[i]; f32x4 y = (v[i] - mean) * rstd * g4 + b4;
#pragma unroll
            for (int e = 0; e < 4; ++e) y[e] = y[e] * sigmoidf_(y[e]);
            u32x2 o; o.x = cvt_pk_bf16(y[0], y[1]); o.y = cvt_pk_bf16(y[2], y[3]);
            *(u32x2*)(CAT + (size_t)(row0 + t) * 1024 + 512 + c0) = o; }
    }
    __syncthreads();
}
constexpr int OA_STRIDE = 68;
constexpr int OB_STRIDE = 144;
constexpr int AT_ML = 512 * OB_STRIDE;
constexpr int AT_VST = AT_ML + 4096;
constexpr int VS_STRIDE = 160;
struct AtTask { int bh, pos0, dsh, L, r, lq0, qoff; };
__device__ __forceinline__ AtTask at_task(int item, int i, int wave) {
    AtTask T; const int span = item & 31; T.bh = item >> 5; T.pos0 = span * 256;
    const int pat = i >> 1, t = wave + 8 * (i & 1);
    T.dsh = 2 * pat; T.L = SEQ >> T.dsh;
    if (pat == 0) { T.r = 0; T.lq0 = T.pos0 + 16 * t; T.qoff = 16 * t; }
    else if (pat == 1) { T.r = t >> 2; T.lq0 = (T.pos0 >> 2) + 16 * (t & 3); T.qoff = 64 * (t & 3) + T.r; }
    else { T.r = t; T.lq0 = T.pos0 >> 4; T.qoff = T.r; }
    return T;
}
__device__ __forceinline__ void at_load_qk(const Args& A, const AtTask& T, int q16, int g, bf16x8 (&kf)[18], bf16x8 (&qf)[2]) {
    const size_t hb = ((size_t)(T.bh >> 4) * SEQ * 1024 + (T.bh & 15) * 64) * 2;
    const char* Qb = (const char*)(A.ws + WS_Q) + hb; const char* Kb = (const char*)(A.ws + WS_K) + hb;
    const unsigned qo = (unsigned)(((T.lq0 + q16) << T.dsh) + T.r) * 2048u + 16u * g;
    qf[0] = *(const bf16x8*)(Qb + qo); qf[1] = *(const bf16x8*)(Qb + qo + 64);
#pragma unroll
    for (int tile = 0; tile < 9; ++tile) {
        int lk = T.lq0 - 64 + 16 * tile + q16; lk = lk < 0 ? 0 : (lk > T.L - 1 ? T.L - 1 : lk);
        const unsigned ko = (unsigned)((lk << T.dsh) + T.r) * 2048u + 16u * g;
        kf[2 * tile] = *(const bf16x8*)(Kb + ko); kf[2 * tile + 1] = *(const bf16x8*)(Kb + ko + 64);
    }
}
template <int I0, int I1, int NR> __device__ __forceinline__ void at_load_v(const Args& A, const AtTask& T, int lane, u32x4 (&vr)[NR]) {
    const char* Vb = (const char*)(A.ws + WS_V) + ((size_t)(T.bh >> 4) * SEQ * 1024 + (T.bh & 15) * 64) * 2;
#pragma unroll
    for (int idx = I0; idx < I1; ++idx) { const int row = 8 * idx + (lane >> 3);
        int lk = T.lq0 - 64 + row; lk = lk < 0 ? 0 : (lk > T.L - 1 ? T.L - 1 : lk);
        vr[idx - I0] = *(const u32x4*)(Vb + ((unsigned)((lk << T.dsh) + T.r) * 2048u + 16u * (lane & 7))); }
}
typedef float f32x16 __attribute__((ext_vector_type(16)));
struct At32 { int bh, dsh, r, lq0, qoff, mode; };
__device__ __forceinline__ void at32_load_qk(const Args& A, const At32& T, int lane, bf16x8 (&qf)[4], bf16x8 (&kf)[5][4]) {
    const int L = SEQ >> T.dsh, q32 = lane & 31, h = lane >> 5, lk0 = T.lq0 - 64;
    const size_t hb = ((size_t)(T.bh >> 4) * SEQ * 1024 + (T.bh & 15) * 64) * 2;
    const char* Qb = (const char*)(A.ws + WS_Q) + hb; const char* Kb = (const char*)(A.ws + WS_K) + hb;
    const unsigned qo = (unsigned)(((T.lq0 + q32) << T.dsh) + T.r) * 2048u + 16u * h;
#pragma unroll
    for (int ds = 0; ds < 4; ++ds) qf[ds] = *(const bf16x8*)(Qb + qo + 32 * ds);
#pragma unroll
    for (int tile = 0; tile < 5; ++tile) { int lk = lk0 + 32 * tile + q32; lk = lk < 0 ? 0 : (lk > L - 1 ? L - 1 : lk);
        const unsigned ko = (unsigned)((lk << T.dsh) + T.r) * 2048u + 16u * h;
#pragma unroll
        for (int ds = 0; ds < 4; ++ds) kf[tile][ds] = *(const bf16x8*)(Kb + ko + 32 * ds); }
}
__device__ __forceinline__ void at_task32(const Args& A, const At32& T, const At32& Tn, bf16x8 (&qf)[4], bf16x8 (&kf)[5][4], LAS unsigned char* lds, LAS unsigned char* vst, int lane) {
    const int bh = T.bh, dsh = T.dsh, r = T.r, lq0 = T.lq0, qoff = T.qoff, mode = T.mode;
    LAS float* ML = (LAS float*)(lds + AT_ML);
    const int L = SEQ >> dsh, q32 = lane & 31, h = lane >> 5, lk0 = lq0 - 64;
    const size_t hb = ((size_t)(bh >> 4) * SEQ * 1024 + (bh & 15) * 64) * 2;
    const char* Vb = (const char*)(A.ws + WS_V) + hb;
    f32x16 s[5];
#define AT32_LOADK(t0, t1) do { _Pragma("unroll") for (int tile = (t0); tile < (t1); ++tile) { int lk = lk0 + 32 * tile + q32; lk = lk < 0 ? 0 : (lk > L - 1 ? L - 1 : lk); \
        const unsigned ko = (unsigned)((lk << dsh) + r) * 2048u + 16u * h; _Pragma("unroll") for (int ds = 0; ds < 4; ++ds) kf[tile][ds] = *(const bf16x8*)(Kb + ko + 32 * ds); } } while (0)
#define AT32_QK(t0, t1) do { _Pragma("unroll") for (int tile = (t0); tile < (t1); ++tile) { f32x16 z; _Pragma("unroll") for (int e = 0; e < 16; ++e) z[e] = 0.f; \
        _Pragma("unroll") for (int ds = 0; ds < 4; ++ds) z = __builtin_amdgcn_mfma_f32_32x32x16_bf16(kf[tile][ds], qf[ds], z, 0, 0, 0); s[tile] = z; } } while (0)
    AT32_QK(0, 3);
    __builtin_amdgcn_sched_barrier(0);
    AT32_QK(3, 5);
    __builtin_amdgcn_sched_barrier(0);
#undef AT32_LOADK
#undef AT32_QK
#pragma unroll
    for (int e = 0; e < 16; ++e) { const int cr = (e & 3) + 8 * (e >> 2) + 4 * h; if (cr - q32 < 0) s[0][e] = -1e30f; if (128 + cr - q32 > 128) s[4][e] = -1e30f; }
    if (lk0 < 0 || lk0 + 159 >= L) {
#pragma unroll
        for (int tile = 0; tile < 5; ++tile)
#pragma unroll
            for (int e = 0; e < 16; ++e) { const int lk = lk0 + 32 * tile + (e & 3) + 8 * (e >> 2) + 4 * h; if (lk < 0 || lk >= L) s[tile][e] = -1e30f; }
    }
    float mx = -1e30f;
#pragma unroll
    for (int tile = 0; tile < 5; ++tile)
#pragma unroll
        for (int e = 0; e < 16; ++e) mx = fmaxf(mx, s[tile][e]);
    { auto rr = __builtin_amdgcn_permlane32_swap(__float_as_uint(mx), __float_as_uint(mx), false, false); mx = fmaxf(__uint_as_float(rr[0]), __uint_as_float(rr[1])); }
    float lsum = 0.f;
#pragma unroll
    for (int tile = 0; tile < 5; ++tile)
#pragma unroll
        for (int e = 0; e < 16; ++e) { const float p = __builtin_amdgcn_exp2f(s[tile][e] - mx); s[tile][e] = p; lsum += p; }
    { auto rr = __builtin_amdgcn_permlane32_swap(__float_as_uint(lsum), __float_as_uint(lsum), false, false); lsum = __uint_as_float(rr[0]) + __uint_as_float(rr[1]); }
    __builtin_amdgcn_sched_barrier(0);
    u32x4 vr[8];
#pragma unroll
    for (int idx = 0; idx < 8; ++idx) { const int row = 8 * idx + (lane >> 3); int lk = lk0 + row; lk = lk < 0 ? 0 : (lk > L - 1 ? L - 1 : lk);
        vr[idx] = *(const u32x4*)(Vb + ((unsigned)((lk << dsh) + r) * 2048u + 16u * (lane & 7))); }
    f32x16 o[2];
#pragma unroll
    for (int db = 0; db < 2; ++db)
#pragma unroll
        for (int e = 0; e < 16; ++e) o[db][e] = 0.f;
    const int i16 = lane & 15;
    const LAS unsigned char* trb = vst + (4 * h + (i16 >> 2)) * VS_STRIDE + (((lane >> 4) & 1) * 16 + 4 * (i16 & 3)) * 2;
#pragma unroll
    for (int tile = 0; tile < 5; ++tile) {
#pragma unroll
        for (int it = 0; it < 4; ++it) { const int idx = it * 64 + lane, row = idx >> 3, ch = idx & 7; *(LAS u32x4*)(vst + row * VS_STRIDE + ch * 16) = vr[(tile & 1) * 4 + it]; }
        if (tile < 3) {
#pragma unroll
            for (int it = 0; it < 4; ++it) { const int row = 32 * (tile + 2) + 8 * it + (lane >> 3); int lk = lk0 + row; lk = lk < 0 ? 0 : (lk > L - 1 ? L - 1 : lk);
                vr[(tile & 1) * 4 + it] = *(const u32x4*)(Vb + ((unsigned)((lk << dsh) + r) * 2048u + 16u * (lane & 7))); }
        }
        bf16x8 pf[2];
#pragma unroll
        for (int ks = 0; ks < 2; ++ks) { u32x4 pw; pw.x = cvt_pk_bf16(s[tile][8 * ks + 0], s[tile][8 * ks + 1]); pw.y = cvt_pk_bf16(s[tile][8 * ks + 2], s[tile][8 * ks + 3]);
            pw.z = cvt_pk_bf16(s[tile][8 * ks + 4], s[tile][8 * ks + 5]); pw.w = cvt_pk_bf16(s[tile][8 * ks + 6], s[tile][8 * ks + 7]); pf[ks] = __builtin_bit_cast(bf16x8, pw); }
        asm volatile("s_waitcnt lgkmcnt(0)" ::: "memory");
#pragma unroll
        for (int ks = 0; ks < 2; ++ks)
#pragma unroll
            for (int db = 0; db < 2; ++db) { const bf16x8 af = tr_pair(trb + (16 * ks) * VS_STRIDE + db * 64, trb + (16 * ks + 8) * VS_STRIDE + db * 64);
                o[db] = __builtin_amdgcn_mfma_f32_32x32x16_bf16(af, pf[ks], o[db], 0, 0, 0); }
        asm volatile("s_waitcnt lgkmcnt(0)" ::: "memory");
    }
    asm volatile("" ::: "memory");
    at32_load_qk(A, Tn, lane, qf, kf);
    asm volatile("" ::: "memory");
    const int ql = qoff + (q32 << dsh);
    LAS unsigned char* orow = lds + ql * OB_STRIDE + 8 * h;
    float ca = 0.f, cbb = 1.f, mn = mx, ln = lsum;
    if (mode != 0) { const f32x2 ml = *(const LAS f32x2*)(ML + 2 * ql); mn = fmaxf(ml[0], mx); ca = __builtin_amdgcn_exp2f(ml[0] - mn); cbb = __builtin_amdgcn_exp2f(mx - mn); ln = ca * ml[1] + cbb * lsum; }
    if (mode == 2) { const float inv = __builtin_amdgcn_rcpf(ln); ca *= inv; cbb *= inv; }
#pragma unroll
    for (int db = 0; db < 2; ++db) {
        u32x2 oldw[4];
#pragma unroll
        for (int rg = 0; rg < 4; ++rg) oldw[rg] = mode != 0 ? *(const LAS u32x2*)(orow + (32 * db + 8 * rg) * 2) : (u32x2){0u, 0u};
#pragma unroll
        for (int rg = 0; rg < 4; ++rg) { u32x2 w;
            w.x = cvt_pk_bf16(bf_lo(oldw[rg].x) * ca + o[db][4 * rg] * cbb, bf_hi(oldw[rg].x) * ca + o[db][4 * rg + 1] * cbb);
            w.y = cvt_pk_bf16(bf_lo(oldw[rg].y) * ca + o[db][4 * rg + 2] * cbb, bf_hi(oldw[rg].y) * ca + o[db][4 * rg + 3] * cbb);
            *(LAS u32x2*)(orow + (32 * db + 8 * rg) * 2) = w; }
        asm volatile("" ::: "memory");
    }
    if (mode != 2 && h == 0) *(LAS f32x2*)(ML + 2 * ql) = (f32x2){mn, ln};
}
__device__ __forceinline__ void at_task16_last(const Args& A, const AtTask& cur, LAS unsigned char* lds, LAS unsigned char* vst, int lane) {
    LAS float* Oacc = (LAS float*)lds; LAS float* ML = (LAS float*)(lds + AT_ML);
    const int q16 = lane & 15, g = lane >> 4;
    const LAS unsigned char* trb = vst + (4 * g + (q16 >> 2)) * VS_STRIDE + (4 * (q16 & 3)) * 2;
    bf16x8 kf[18], qf[2]; u32x4 vr[18];
    at_load_qk(A, cur, q16, g, kf, qf);
    f32x4 s[9];
#pragma unroll
    for (int tile = 0; tile < 9; ++tile) {
        f32x4 z = (f32x4){0.f, 0.f, 0.f, 0.f};
        z = __builtin_amdgcn_mfma_f32_16x16x32_bf16(kf[2 * tile], qf[0], z, 0, 0, 0);
        s[tile] = __builtin_amdgcn_mfma_f32_16x16x32_bf16(kf[2 * tile + 1], qf[1], z, 0, 0, 0);
    }
    at_load_v<0, 18, 18>(A, cur, lane, vr);
    const int lk0 = cur.lq0 - 64;
#pragma unroll
    for (int e = 0; e < 4; ++e) { if (4 * g + e - q16 < 0) s[0][e] = -1e30f; if (128 + 4 * g + e - q16 > 128) s[8][e] = -1e30f; }
    if (lk0 < 0 || lk0 + 143 >= cur.L) {
#pragma unroll
        for (int tile = 0; tile < 9; ++tile)
#pragma unroll
            for (int e = 0; e < 4; ++e) { const int lk = lk0 + 16 * tile + 4 * g + e; if (lk < 0 || lk >= cur.L) s[tile][e] = -1e30f; }
    }
    float mx = -1e30f;
#pragma unroll
    for (int tile = 0; tile < 9; ++tile) mx = fmaxf(fmaxf(mx, fmaxf(s[tile][0], s[tile][1])), fmaxf(s[tile][2], s[tile][3]));
    mx = fmaxf(mx, __shfl_xor(mx, 16)); mx = fmaxf(mx, __shfl_xor(mx, 32));
    float lsum = 0.f;
#pragma unroll
    for (int tile = 0; tile < 9; ++tile)
#pragma unroll
        for (int e = 0; e < 4; ++e) { const float p = __builtin_amdgcn_exp2f(s[tile][e] - mx); s[tile][e] = p; lsum += p; }
    lsum += __shfl_xor(lsum, 16); lsum += __shfl_xor(lsum, 32);
    bf16x8 pf[5];
#pragma unroll
    for (int ks = 0; ks < 5; ++ks) { const f32x4 p0 = s[2 * ks]; f32x4 p1 = (f32x4){0.f, 0.f, 0.f, 0.f}; if (2 * ks + 1 < 9) p1 = s[2 * ks + 1 < 9 ? 2 * ks + 1 : 8];
        u32x4 pw; pw.x = cvt_pk_bf16(p0[0], p0[1]); pw.y = cvt_pk_bf16(p0[2], p0[3]); pw.z = cvt_pk_bf16(p1[0], p1[1]); pw.w = cvt_pk_bf16(p1[2], p1[3]); pf[ks] = __builtin_bit_cast(bf16x8, pw); }
    f32x4 o[4];
#pragma unroll
    for (int db = 0; db < 4; ++db) o[db] = (f32x4){0.f, 0.f, 0.f, 0.f};
#pragma unroll
    for (int ks = 0; ks < 5; ++ks) {
#pragma unroll
        for (int it = 0; it < 4; ++it) { if (ks * 4 + it < 18) { const int idx = it * 64 + lane, row = idx >> 3, ch = idx & 7; *(LAS u32x4*)(vst + row * VS_STRIDE + ch * 16) = vr[ks * 4 + it < 18 ? ks * 4 + it : 0]; } }
        asm volatile("s_waitcnt lgkmcnt(0)" ::: "memory");
#pragma unroll
        for (int db = 0; db < 4; ++db) { const bf16x8 af = tr_pair(trb + db * 32, trb + 16 * VS_STRIDE + db * 32); o[db] = __builtin_amdgcn_mfma_f32_16x16x32_bf16(af, pf[ks], o[db], 0, 0, 0); }
        asm volatile("s_waitcnt lgkmcnt(0)" ::: "memory");
    }
    const int ql = cur.qoff + (q16 << cur.dsh);
    LAS float* orow = Oacc + ql * OA_STRIDE + 4 * g;
    const f32x2 ml = *(const LAS f32x2*)(ML + 2 * ql);
    const float mn = fmaxf(ml[0], mx), ca = __builtin_amdgcn_exp2f(ml[0] - mn), cbb = __builtin_amdgcn_exp2f(mx - mn), ln = ca * ml[1] + cbb * lsum;
    f32x4 on[4];
#pragma unroll
    for (int db = 0; db < 4; ++db) on[db] = *(const LAS f32x4*)(orow + 16 * db) * ca + o[db] * cbb;
    asm volatile("s_waitcnt lgkmcnt(0)" ::: "memory");
    const float inv = 1.0f / ln;
    LAS unsigned char* brow = (LAS unsigned char*)(Oacc + ql * OA_STRIDE);
#pragma unroll
    for (int db = 0; db < 4; ++db) { const f32x4 v = on[db] * inv; u32x2 w; w.x = cvt_pk_bf16(v[0], v[1]); w.y = cvt_pk_bf16(v[2], v[3]); *(LAS u32x2*)(brow + (16 * db + 4 * g) * 2) = w; }
}
__device__ __forceinline__ void attn_phase(const Args& A, LAS unsigned char* lds, int tid, int lane, int wave, int bx, int G) {
    LAS unsigned char* vst = lds + AT_VST + wave * (32 * VS_STRIDE);
    const bool xmap = (G == 256);
#define AT_ITEM(k) (xmap ? ((((bx & 7) * 4 + (((k) * 32 + (bx >> 3)) >> 4)) << 4) | (((k) * 32 + (bx >> 3)) & 15)) : (bx + (k) * G))
#define AT_VALID(k) (xmap ? ((k) < 2) : (bx + (k) * G < 512))
#define AT_TASK(T_, item_, i_) do { const int span_ = (item_) & 15, pos0_ = span_ * 512, pat_ = (i_) >> 1, t_ = wave + 8 * ((i_) & 1); (T_).bh = (item_) >> 4; (T_).mode = pat_; \
        if (pat_ == 0) { (T_).dsh = 0; (T_).r = 0; (T_).lq0 = pos0_ + 32 * t_; (T_).qoff = 32 * t_; } \
        else if (pat_ == 1) { (T_).dsh = 2; (T_).r = t_ >> 2; (T_).lq0 = (pos0_ >> 2) + 32 * (t_ & 3); (T_).qoff = 128 * (t_ & 3) + (t_ >> 2); } \
        else { (T_).dsh = 4; (T_).r = t_; (T_).lq0 = pos0_ >> 4; (T_).qoff = t_; } } while (0)
    if (!AT_VALID(0)) return;
    bf16x8 qf[4], kf[5][4];
    At32 cur; AT_TASK(cur, AT_ITEM(0), 0);
    at32_load_qk(A, cur, lane, qf, kf);
#pragma unroll 1
    for (int kstep = 0; AT_VALID(kstep); ++kstep) {
        const int item = AT_ITEM(kstep), span = item & 15, bh = item >> 4, pos0 = span * 512;
#pragma unroll 1
        for (int i = 0; i < 6; ++i) {
            At32 nxt;
            if (i < 5) { AT_TASK(nxt, item, i + 1); } else { const int ni = AT_VALID(kstep + 1) ? AT_ITEM(kstep + 1) : item; AT_TASK(nxt, ni, 0); }
            at_task32(A, cur, nxt, qf, kf, lds, vst, lane);
            cur = nxt;
            if (i & 1) asm volatile("s_waitcnt lgkmcnt(0)\n\ts_barrier" ::: "memory");
        }
        {
            bf16_t* Op = (bf16_t*)(A.ws + WS_O) + (size_t)(bh >> 4) * SEQ * 1024 + (bh & 15) * 64;
#pragma unroll
            for (int rd = 0; rd < 8; ++rd) { const int idx = rd * NTHR + tid, row = idx >> 3, ch = idx & 7;
                const u32x4 v = *(const LAS u32x4*)(lds + row * OB_STRIDE + ch * 16);
                *(u32x4*)(Op + (size_t)(pos0 + row) * 1024 + ch * 8) = v; }
        }
        asm volatile("s_waitcnt lgkmcnt(0)\n\ts_barrier" ::: "memory");
    }
#undef AT_TASK
}

#define XB_TMO      128
#define XB_XCNT(j)  (256  + 64 * (j))
#define XB_XSUB(j)  (1280 + 64 * (j))
#define XB_XGEN(j)  (2304 + 64 * (j))
#define XB_TOP      3328
#define XB_TOPGEN   3392
#define XCD_BAR_WORDS 3456
#define XB_SPIN_CAP (1u << 18)

__device__ __forceinline__ unsigned xb_ld(unsigned* p)              { return __hip_atomic_load(p, __ATOMIC_RELAXED, __HIP_MEMORY_SCOPE_AGENT); }
__device__ __forceinline__ unsigned xb_add(unsigned* p, unsigned v) { return __hip_atomic_fetch_add(p, v, __ATOMIC_RELAXED, __HIP_MEMORY_SCOPE_AGENT); }
__device__ __forceinline__ unsigned xb_xcc_id() { return (unsigned)__builtin_amdgcn_s_getreg((3 << 11) | 20) & 0xFu; }
#define XB_SPIN(cond, bar) do { unsigned _sp = 0; while (cond) { __builtin_amdgcn_s_sleep(1); \
    if ((++_sp & 255u) == 0u) { if (xb_ld(&(bar)[XB_TMO])) break; if (_sp > XB_SPIN_CAP) { atomicAdd(&(bar)[XB_TMO], 1u); break; } } } } while (0)

struct XcdBarrier {
    unsigned* bar; unsigned x;
    volatile LAS unsigned* st;
};

__device__ __forceinline__ XcdBarrier xcd_barrier_post(unsigned* bar, volatile LAS unsigned* st) {
    XcdBarrier b; b.bar = bar; b.x = xb_xcc_id(); b.st = st;
    if (threadIdx.x == 0) (void)xb_add(&bar[XB_XCNT(b.x)], 1u);
    return b;
}
__device__ __forceinline__ void xcd_barrier_complete(unsigned* bar, unsigned x, unsigned& nloc, unsigned& nx) {
    const unsigned G = gridDim.x * gridDim.y * gridDim.z;
    unsigned sum, cnt, mine, sp = 0u;
    for (;;) {
        sum = 0u; cnt = 0u; mine = 0u;
#pragma unroll
        for (unsigned j = 0; j < 16; ++j) { const unsigned c = xb_ld(&bar[XB_XCNT(j)]); sum += c; cnt += (c > 0u) ? 1u : 0u; mine = (j == x) ? c : mine; }
        if (sum == G) break;
        __builtin_amdgcn_s_sleep(1);
        if ((++sp & 255u) == 0u) { if (xb_ld(&bar[XB_TMO])) break; if (sp > XB_SPIN_CAP) { atomicAdd(&bar[XB_TMO], 1u); break; } }
    }
    nloc = mine > 0u ? mine : 1u; nx = cnt > 0u ? cnt : 1u;
}

__device__ __forceinline__ void xcd_barrier(const XcdBarrier& b) {
    asm volatile("s_waitcnt vmcnt(0)" ::: "memory");
    __syncthreads();
    if (threadIdx.x == 0) {
        unsigned* bar = b.bar;
        __builtin_amdgcn_s_waitcnt(0);
        unsigned nloc = b.st[0], nx = b.st[1];
        if (nloc == 0u) { xcd_barrier_complete(bar, b.x, nloc, nx); b.st[0] = nloc; b.st[1] = nx; }
        const unsigned old = xb_add(&bar[XB_XSUB(b.x)], 1u);
        const unsigned gen = old / nloc;
        if (old + 1u == (gen + 1u) * nloc) {
            __builtin_amdgcn_fence(__ATOMIC_RELEASE, "agent");
            asm volatile("s_waitcnt vmcnt(0)" ::: "memory");
            const unsigned og = xb_add(&bar[XB_TOP], 1u);
            const unsigned tg = og / nx;
            if (og + 1u == (tg + 1u) * nx) xb_add(&bar[XB_TOPGEN], 1u);
            else XB_SPIN(xb_ld(&bar[XB_TOPGEN]) == tg, bar);
            __builtin_amdgcn_fence(__ATOMIC_ACQUIRE, "agent");
            asm volatile("s_waitcnt vmcnt(0)" ::: "memory");
        } else {
            XB_SPIN(xb_ld(&bar[XB_TOPGEN]) == gen, bar);
            __builtin_amdgcn_fence(__ATOMIC_ACQUIRE, "agent");
            asm volatile("s_waitcnt vmcnt(0)" ::: "memory");
        }
    }
    __syncthreads();
}

__global__ void __launch_bounds__(NTHR, 2) mega_fwd(Args A) {
    extern __shared__ __attribute__((aligned(16))) unsigned char lds_raw[];
    LAS unsigned char* lds = (LAS unsigned char*)lds_raw;
    const int G = gridDim.x, bx = blockIdx.x;
    volatile LAS unsigned* bst = (volatile LAS unsigned*)(lds + LDS_BYTES - 16);
    if (threadIdx.x < 4) bst[threadIdx.x] = 0u;
    __syncthreads();
    XcdBarrier bar; bar.bar = (unsigned*)A.ws; bar.x = 0; bar.st = bst;
    if (A.coop) bar = xcd_barrier_post((unsigned*)A.ws, bst);
    int ph = 0;
#define PHASE_BEGIN if (ph >= A.ph_lo && ph < A.ph_hi) { int tid = threadIdx.x; asm volatile("" : "+v"(tid)); const int lane = tid & 63, wave = __builtin_amdgcn_readfirstlane(tid >> 6); unsigned char* ws = A.ws; asm volatile("" : "+s"(ws)); bf16_t* xb = (bf16_t*)(ws + WS_XB); float* rowsq = (float*)(ws + WS_ROWSQ);
#define PHASE_END   if (A.coop && ph + 1 < A.ph_hi) { if (A.pad == 0x7fffffff) cg::this_grid().sync();   xcd_barrier(bar); } } ++ph;
#ifndef REP_MASK
#define REP_MASK 0
#endif
#define REP_BEGIN(bit) for (int rep_ = 0; rep_ < (((REP_MASK) & (bit)) ? 2 : 1); ++rep_) { if (rep_) cg::this_grid().sync();
#define REP_END }
    PHASE_BEGIN
        REP_BEGIN(1)
#if EN & 1
 p0_prologue(A, lds, tid, lane, wave);
#endif
        REP_END
 PHASE_END
#pragma unroll 1
    for (int layer = 0; layer < 4; ++layer) {
        const int li = layer >> 1; const bool even = (layer & 1) == 0;
        PHASE_BEGIN
        REP_BEGIN(2)
#if EN & 2
        if (even) { pg8::Gemm g{xb, (const bf16_t*)(ws + WS_ABIN + li * 4 * MiB), M, 2048, D}; pg8::StaticOrder S; S.init(M, 2048, G, bx, WG_G1);
            pg8::EpiZ E{(bf16_t*)(ws + WS_UV), (bf16_t*)(ws + WS_GB), rowsq, (LAS float*)(lds + 131072)};
            pg8::gemm_phase<pg8::EpiZ, pg8::StaticOrder, true, true>(lds, g, S, E); }
#endif
#if EN & 4
        if (!even) { pg8::Gemm g{xb, (const bf16_t*)(ws + WS_QKV + li * 6 * MiB), M, 3072, D}; pg8::StaticOrder S; S.init(M, 3072, G, bx, WG_G1);
            pg8::EpiQKV E{(bf16_t*)(ws + WS_Q), (bf16_t*)(ws + WS_K), (bf16_t*)(ws + WS_V), rowsq, A.in[16] + li * 64, A.in[17] + li * 64, (const float*)(ws + WS_ROPEC), (const float*)(ws + WS_ROPES), (LAS float*)(lds + 131072)};
            pg8::gemm_phase<pg8::EpiQKV, pg8::StaticOrder, true, true>(lds, g, S, E); }
#endif
        REP_END
        PHASE_END
        PHASE_BEGIN
        REP_BEGIN(even ? 4 : 8)
#if EN & 8
        if (even) { for (int it = bx; it < 768; it += G) {
#ifndef NO_MIXA
 if (it < 256) { mixa_item(A, li, it, lds, tid, lane, wave);
#ifdef DUP_MIXA
 mixa_item(A, li, it, lds, tid, lane, wave);
#endif
 }
#endif
#ifndef NO_MIXB
 if (it >= 256) { mixb_item(A, li, it - 256, lds, tid, lane, wave);
#ifdef DUP_MIXB
 mixb_item(A, li, it - 256, lds, tid, lane, wave);
#endif
 }
#endif
 } }
#endif
#if EN & 16
        if (!even) { if (wave >= 4) __builtin_amdgcn_s_setprio(1);     attn_phase(A, lds, tid, lane, wave, bx, G); __builtin_amdgcn_s_setprio(0); }
#endif
        REP_END
        PHASE_END
        PHASE_BEGIN
#if EN & 32
        { pg8::Gemm g{(const bf16_t*)(ws + (even ? WS_CAT : WS_O)), (const bf16_t*)(ws + (even ? WS_ABOUT : WS_COUT) + li * 2 * MiB), M, D, D}; pg8::StaticOrder S; S.init(M, D, G, bx, WG_G2);
          pg8::EpiRes E{xb, rowsq, nullptr};
          pg8::gemm_phase<pg8::EpiRes, pg8::StaticOrder, true, true>(lds, g, S, E); }
#endif
        PHASE_END
        PHASE_BEGIN
        REP_BEGIN(16)
#if EN & 64
        { pg8::Gemm g{xb, (const bf16_t*)(ws + WS_W1 + layer * 8 * MiB), M, FF, D}; pg8::StaticOrder S; S.init(M, FF, G, bx, WG_G3);
          pg8::EpiW1 E{(bf16_t*)(ws + WS_BIG), rowsq, (LAS float*)(lds + 131072)};
          pg8::gemm_phase<pg8::EpiW1, pg8::StaticOrder, true, true>(lds, g, S, E); }
#endif
        REP_END
        PHASE_END
        PHASE_BEGIN
#if EN & 128
        { pg8::Gemm g{(const bf16_t*)(ws + WS_BIG), (const bf16_t*)(ws + WS_W2 + layer * 8 * MiB), M, D, FF}; pg8::StaticOrder S; S.init(M, D, G, bx, WG_G4);
          pg8::EpiRes E{xb, rowsq, layer == 3 ? A.out : nullptr};
          pg8::gemm_phase<pg8::EpiRes, pg8::StaticOrder, true, true>(lds, g, S, E); }
#endif
        PHASE_END
    }
}
constexpr int N_PHASES = 21;
#ifndef MK_MULTI
#define MK_MULTI 0
#endif
extern "C" void kernel_launch(void* const* d_in, const int* in_sizes, int n_in, void* d_out, int out_size, void* d_ws, size_t ws_size, hipStream_t stream) {
    static int grid = 0;
    if (grid == 0) {
        if (n_in != 19 || out_size != M * D || ws_size < WS_END) { fprintf(stderr, "kernel_launch: unexpected shapes n_in %d out %d ws %zu\n", n_in, out_size, ws_size); grid = -1; return; }
        int dev = 0, cus = 0, per_cu = 0;
        hipGetDevice(&dev); hipDeviceGetAttribute(&cus, hipDeviceAttributeMultiprocessorCount, dev);
        hipFuncSetAttribute((const void*)mega_fwd, hipFuncAttributeMaxDynamicSharedMemorySize, LDS_BYTES);
        hipOccupancyMaxActiveBlocksPerMultiprocessor(&per_cu, (const void*)mega_fwd, NTHR, LDS_BYTES);
        if (per_cu < 1) { fprintf(stderr, "kernel_launch: occupancy query says %d blocks per CU\n", per_cu); per_cu = 1; }
        (void)hipGetLastError();
        grid = cus * (per_cu > 1 ? 1 : per_cu);
        fprintf(stderr, "kernel_launch: grid %d (cus %d per_cu %d)\n", grid, cus, per_cu);
    }
    if (grid < 0) return;
    Args a{};
    for (int i = 0; i < 19; ++i) a.in[i] = (const float*)d_in[i];
    a.out = (float*)d_out; a.ws = (unsigned char*)d_ws;
#if MK_MULTI
    for (int p = 0; p < N_PHASES; ++p) { a.coop = 0; a.ph_lo = p; a.ph_hi = p + 1; hipLaunchKernelGGL(mega_fwd, dim3(grid), dim3(NTHR), LDS_BYTES, stream, a); }
#else
    hipMemsetAsync(d_ws, 0, 16384, stream);
    a.coop = 1; a.ph_lo = 0; a.ph_hi = N_PHASES;
    void* args[] = {&a};
    hipError_t e = hipLaunchCooperativeKernel((const void*)mega_fwd, dim3(grid), dim3(NTHR), args, LDS_BYTES, stream);
    if (e != hipSuccess) fprintf(stderr, "cooperative launch failed: %s (grid %d)\n", hipGetErrorString(e), grid);
#endif
}
```
